# Optimizing an MI355X kernel written in HIP

```python
import jax, jax.numpy as jnp
from jax import lax
import numpy as np

D_MODEL = 1024
BATCH = 8
SEQ = 4096
DEPTH = 2

CTX_LEN = 256
GRID_W = 64
D_FF = 2816
N_MOD = 9
EPS = 1e-6
ROPE_BASE = 10000.0
Q_BLOCK = 128
MLA_HEADS = 8
MLA_NOPE = 64
MLA_ROPE = 32
MLA_V = 64
MLA_Q_LORA = 384
MLA_KV_LORA = 256
CONV_CH = 512
CONV_WIDTH = 31
HEAD_DIM = 64
GQA_HEADS = 8
GQA_KV_HEADS = 2
NA_HEADS = 8
WIN_H = 8
WIN_W = 16

EVEN_KV_COLS = MLA_KV_LORA + MLA_ROPE
EVEN_CONV_OFF = EVEN_KV_COLS + MLA_Q_LORA
EVEN_COLS = EVEN_CONV_OFF + 2 * CONV_CH
GQA_KV_W = GQA_KV_HEADS * HEAD_DIM
GQA_Q_W = GQA_HEADS * HEAD_DIM
NA_W = NA_HEADS * HEAD_DIM
ODD_KV_COLS = 2 * GQA_KV_W + 2 * NA_W
ODD_COLS = ODD_KV_COLS + GQA_Q_W + NA_W
MIX_OUT = MLA_HEADS * MLA_V + CONV_CH

kernel_name = "hybrid_conv_mla_gqa_natten_dit_block"


def rms_norm(x, g):
    xf = x.astype(jnp.float32)
    y = xf * lax.rsqrt(jnp.mean(xf * xf, axis=-1, keepdims=True) + EPS)
    return (y * g.astype(jnp.float32)).astype(x.dtype)


def layer_norm(x, g, b):
    xf = x.astype(jnp.float32)
    mu = jnp.mean(xf, axis=-1, keepdims=True)
    var = jnp.mean(jnp.square(xf - mu), axis=-1, keepdims=True)
    y = (xf - mu) * lax.rsqrt(var + EPS)
    return (y * g.astype(jnp.float32) + b.astype(jnp.float32)).astype(x.dtype)


def axial_rope_table(n_tokens, dim):
    t = jnp.arange(n_tokens)
    row = (t // GRID_W).astype(jnp.float32)
    col = (t % GRID_W).astype(jnp.float32)
    n_pairs = dim // 4
    inv = ROPE_BASE ** (-jnp.arange(n_pairs, dtype=jnp.float32) / n_pairs)
    ang = jnp.concatenate([row[:, None] * inv, col[:, None] * inv], axis=-1)
    return jnp.cos(ang), jnp.sin(ang)


def apply_rope(x, cos, sin):
    xp = x.reshape(*x.shape[:-1], x.shape[-1] // 2, 2)
    x1, x2 = xp[..., 0], xp[..., 1]
    cs = cos[None, :, None, :].astype(x.dtype)
    sn = sin[None, :, None, :].astype(x.dtype)
    return jnp.stack([x1 * cs - x2 * sn, x1 * sn + x2 * cs], axis=-1).reshape(x.shape)


def _attend(q, k, v):
    scale = q.shape[-1] ** -0.5
    s = jnp.einsum('bqhgd,bkhd->bhgqk', q, k).astype(jnp.float32) * scale
    p = jax.nn.softmax(s, axis=-1).astype(v.dtype)
    return jnp.einsum('bhgqk,bkhd->bqhgd', p, v)


def context_attention(q, k, v):
    B, L, Hk, G, _ = q.shape
    return _attend(q, k, v).reshape(B, L, Hk * G, v.shape[-1])


def latent_attention(q, k, v, k_ctx, v_ctx):
    B, S, Hk, G, d = q.shape
    k_all = jnp.concatenate([k_ctx, k], axis=1)
    v_all = jnp.concatenate([v_ctx, v], axis=1)
    qb = q.reshape(B, S // Q_BLOCK, Q_BLOCK, Hk, G, d).transpose(1, 0, 2, 3, 4, 5)
    o = lax.map(lambda qi: _attend(qi, k_all, v_all), qb)
    return o.transpose(1, 0, 2, 3, 4, 5).reshape(B, S, Hk * G, v.shape[-1])


def neighbourhood_attention(q, k, v, k_ctx, v_ctx, rpb):
    B, S, H, d = q.shape
    rows = S // GRID_W
    kh = min(WIN_H, rows)
    scale = d ** -0.5
    qg = q.reshape(B, rows, GRID_W, H, d).transpose(1, 0, 2, 3, 4)
    kg = k.reshape(B, rows, GRID_W, H, d)
    vg = v.reshape(B, rows, GRID_W, H, d)
    col = jnp.arange(GRID_W)
    cs = jnp.clip(col - WIN_W // 2, 0, GRID_W - WIN_W)
    col_idx = cs[:, None] + jnp.arange(WIN_W)[None, :]
    dc = col_idx - col[:, None] + (WIN_W - 1)
    n_ctx = k_ctx.shape[1]

    def row_block(args):
        r, q_r = args
        rs = jnp.clip(r - kh // 2, 0, rows - kh)
        k_rows = lax.dynamic_slice_in_dim(kg, rs, kh, axis=1)
        v_rows = lax.dynamic_slice_in_dim(vg, rs, kh, axis=1)
        k_nb = k_rows[:, :, col_idx]
        v_nb = v_rows[:, :, col_idx]
        s_nb = jnp.einsum('bqhd,bjqwhd->bhqjw', q_r, k_nb).astype(jnp.float32) * scale
        dr = rs + jnp.arange(kh) - r + (WIN_H - 1)
        bias = rpb[:, dr[None, :, None], dc[:, None, :]]
        s_nb = (s_nb + bias[None].astype(jnp.float32)).reshape(B, H, GRID_W, kh * WIN_W)
        s_ctx = jnp.einsum('bqhd,bkhd->bhqk', q_r, k_ctx).astype(jnp.float32) * scale
        p = jax.nn.softmax(jnp.concatenate([s_ctx, s_nb], axis=-1), axis=-1).astype(v.dtype)
        p_ctx = p[..., :n_ctx]
        p_nb = p[..., n_ctx:].reshape(B, H, GRID_W, kh, WIN_W)
        return (jnp.einsum('bhqk,bkhd->bqhd', p_ctx, v_ctx)
                + jnp.einsum('bhqjw,bjqwhd->bqhd', p_nb, v_nb))

    o = lax.map(row_block, (jnp.arange(rows), qg))
    return o.transpose(1, 0, 2, 3, 4).reshape(B, S, H, d)


def swiglu(h, w_in, w_out):
    g, u = jnp.split(h @ w_in, 2, axis=-1)
    return (jax.nn.silu(g) * u) @ w_out


def conv_module(u, prm):
    u = u + prm["conv_glu_b"]
    a, g = jnp.split(u, 2, axis=-1)
    y = a * jax.nn.sigmoid(g)
    y = lax.conv_general_dilated(
        y, prm["conv_dw_w"][:, None, :].astype(y.dtype), window_strides=(1,),
        padding=[(CONV_WIDTH // 2, CONV_WIDTH // 2)],
        dimension_numbers=("NWC", "WIO", "NWC"), feature_group_count=CONV_CH) + prm["conv_dw_b"]
    y = layer_norm(y, prm["conv_ln_g"], prm["conv_ln_b"])
    return jax.nn.silu(y)


def mla_kv(pp, prm, rope):
    B, L, _ = pp.shape
    ckv = rms_norm(pp[..., :MLA_KV_LORA], prm["mla_kv_norm"])
    kvu = (ckv @ prm["mla_w_ukv"]).reshape(B, L, MLA_HEADS, MLA_NOPE + MLA_V)
    k_nope = rms_norm(kvu[..., :MLA_NOPE], prm["mla_k_gain"][:MLA_NOPE])
    v = kvu[..., MLA_NOPE:]
    k_rope = rms_norm(pp[..., MLA_KV_LORA:EVEN_KV_COLS], prm["mla_k_gain"][MLA_NOPE:])[:, :, None, :]
    if rope is not None:
        k_rope = apply_rope(k_rope, *rope)
    k = jnp.concatenate([k_nope, jnp.broadcast_to(k_rope, (B, L, MLA_HEADS, MLA_ROPE))], axis=-1)
    return k, v


def mla_q(pp, prm, rope):
    B, L, _ = pp.shape
    cq = rms_norm(pp[..., EVEN_KV_COLS:EVEN_CONV_OFF], prm["mla_q_norm"])
    q = (cq @ prm["mla_w_uq"]).reshape(B, L, MLA_HEADS, MLA_NOPE + MLA_ROPE)
    q_nope = rms_norm(q[..., :MLA_NOPE], prm["mla_q_gain"][:MLA_NOPE])
    q_rope = rms_norm(q[..., MLA_NOPE:], prm["mla_q_gain"][MLA_NOPE:])
    if rope is not None:
        q_rope = apply_rope(q_rope, *rope)
    return jnp.concatenate([q_nope, q_rope], axis=-1)[:, :, :, None, :]


def even_mixer(hl, hc, prm, ctx_out, ropes):
    rope_mla, _ = ropes
    B, S, _ = hl.shape
    pl = hl @ prm["w_in"]
    pc = hc @ (prm["w_in"] if ctx_out else prm["w_in"][:, :EVEN_KV_COLS])
    k_l, v_l = mla_kv(pl, prm, rope_mla)
    k_c, v_c = mla_kv(pc, prm, None)
    att_l = latent_attention(mla_q(pl, prm, rope_mla), k_l, v_l, k_c, v_c).reshape(B, S, -1)
    conv_l = conv_module(pl[..., EVEN_CONV_OFF:], prm)
    ol = jnp.concatenate([att_l, conv_l], axis=-1) @ prm["w_out"]
    oc = None
    if ctx_out:
        Bc, Lc, _ = hc.shape
        att_c = context_attention(mla_q(pc, prm, None), k_c, v_c).reshape(Bc, Lc, -1)
        conv_c = conv_module(pc[..., EVEN_CONV_OFF:], prm)
        oc = jnp.concatenate([att_c, conv_c], axis=-1) @ prm["w_out"]
    return ol, oc


def odd_kv(pp, prm, rope):
    B, L, _ = pp.shape
    o1, o2, o3 = GQA_KV_W, 2 * GQA_KV_W, 2 * GQA_KV_W + NA_W
    ck = rms_norm(pp[..., :o1].reshape(B, L, GQA_KV_HEADS, HEAD_DIM), prm["gqa_k_gain"])
    if rope is not None:
        ck = apply_rope(ck, *rope)
    cv = pp[..., o1:o2].reshape(B, L, GQA_KV_HEADS, HEAD_DIM)
    nk = rms_norm(pp[..., o2:o3].reshape(B, L, NA_HEADS, HEAD_DIM), prm["na_k_gain"])
    nv = pp[..., o3:ODD_KV_COLS].reshape(B, L, NA_HEADS, HEAD_DIM)
    return ck, cv, nk, nv


def odd_q(pp, prm, rope):
    B, L, _ = pp.shape
    cq = rms_norm(pp[..., ODD_KV_COLS:ODD_KV_COLS + GQA_Q_W].reshape(B, L, GQA_HEADS, HEAD_DIM), prm["gqa_q_gain"])
    if rope is not None:
        cq = apply_rope(cq, *rope)
    cq = cq.reshape(B, L, GQA_KV_HEADS, GQA_HEADS // GQA_KV_HEADS, HEAD_DIM)
    nq = rms_norm(pp[..., ODD_KV_COLS + GQA_Q_W:].reshape(B, L, NA_HEADS, HEAD_DIM), prm["na_q_gain"])
    return cq, nq


def odd_mixer(hl, hc, prm, ctx_out, ropes):
    _, rope_hd = ropes
    B, S, _ = hl.shape
    pl = hl @ prm["w_in"]
    pc = hc @ (prm["w_in"] if ctx_out else prm["w_in"][:, :ODD_KV_COLS])
    ck_l, cv_l, nk_l, nv_l = odd_kv(pl, prm, rope_hd)
    ck_c, cv_c, nk_c, nv_c = odd_kv(pc, prm, None)
    cq_l, nq_l = odd_q(pl, prm, rope_hd)
    gqa_l = latent_attention(cq_l, ck_l, cv_l, ck_c, cv_c).reshape(B, S, -1)
    na_l = neighbourhood_attention(nq_l, nk_l, nv_l, nk_c, nv_c, prm["na_rpb"]).reshape(B, S, -1)
    ol = jnp.concatenate([gqa_l, na_l], axis=-1) @ prm["w_out"]
    oc = None
    if ctx_out:
        Bc, Lc, _ = hc.shape
        cq_c, nq_c = odd_q(pc, prm, None)
        gqa_c = context_attention(cq_c, ck_c, cv_c).reshape(Bc, Lc, -1)
        na_c = context_attention(nq_c[:, :, :, None, :], nk_c, nv_c).reshape(Bc, Lc, -1)
        oc = jnp.concatenate([gqa_c, na_c], axis=-1) @ prm["w_out"]
    return ol, oc


def adaln(cond, prm):
    mod = jax.nn.silu(cond) @ prm["mod_w"] + prm["mod_b"]
    return jnp.split(mod, N_MOD, axis=-1)


def modulate(h, shift, scale):
    return h * (1.0 + scale) + shift


def trunk_layer(xl, xc, c, c_ctx, prm, even, ctx_out, ropes):
    mod_l = adaln(c[:, None, :], prm)
    mod_c = adaln(c_ctx[None, None, :], prm)

    def half_ffn(x, m, name):
        sh, sc, g = m
        h = modulate(rms_norm(x, prm[name + "_norm"]), sh, sc)
        return x + 0.5 * g * swiglu(h, prm[name + "_w_in"], prm[name + "_w_out"])

    xl = half_ffn(xl, mod_l[0:3], "ffn1")
    xc = half_ffn(xc, mod_c[0:3], "ffn1")
    hl = modulate(rms_norm(xl, prm["mix_norm"]), mod_l[3], mod_l[4])
    hc = modulate(rms_norm(xc, prm["mix_norm"]), mod_c[3], mod_c[4])
    mixer = even_mixer if even else odd_mixer
    ol, oc = mixer(hl, hc, prm, ctx_out, ropes)
    xl = xl + mod_l[5] * ol
    xl = half_ffn(xl, mod_l[6:9], "ffn2")
    if ctx_out:
        xc = xc + mod_c[5] * oc
        xc = half_ffn(xc, mod_c[6:9], "ffn2")
    return xl, xc


def _layer_params(key, i):
    ks = iter(jax.random.split(key, 32))

    def nrm(shape, scale):
        return jax.random.normal(next(ks), shape, jnp.float32) * scale

    def gain(n):
        return 1.0 + 0.02 * jax.random.normal(next(ks), (n,), jnp.float32)

    D = D_MODEL
    pre = f"l{i}_"
    p = {}
    p[pre + "mod_w"] = nrm((D, N_MOD * D), 0.5 * D ** -0.5)
    p[pre + "mod_b"] = nrm((N_MOD * D,), 0.02)
    p[pre + "ffn1_norm"] = gain(D)
    p[pre + "ffn1_w_in"] = nrm((D, 2 * D_FF), D ** -0.5)
    p[pre + "ffn1_w_out"] = nrm((D_FF, D), D_FF ** -0.5)
    p[pre + "mix_norm"] = gain(D)
    if i % 2 == 0:
        p[pre + "w_in"] = nrm((D, EVEN_COLS), D ** -0.5)
        p[pre + "mla_q_norm"] = gain(MLA_Q_LORA)
        p[pre + "mla_w_uq"] = nrm((MLA_Q_LORA, MLA_HEADS * (MLA_NOPE + MLA_ROPE)), MLA_Q_LORA ** -0.5)
        p[pre + "mla_kv_norm"] = gain(MLA_KV_LORA)
        p[pre + "mla_w_ukv"] = nrm((MLA_KV_LORA, MLA_HEADS * (MLA_NOPE + MLA_V)), MLA_KV_LORA ** -0.5)
        p[pre + "mla_q_gain"] = gain(MLA_NOPE + MLA_ROPE)
        p[pre + "mla_k_gain"] = gain(MLA_NOPE + MLA_ROPE)
        p[pre + "conv_glu_b"] = nrm((2 * CONV_CH,), 0.02)
        p[pre + "conv_dw_w"] = nrm((CONV_WIDTH, CONV_CH), CONV_WIDTH ** -0.5)
        p[pre + "conv_dw_b"] = nrm((CONV_CH,), 0.02)
        p[pre + "conv_ln_g"] = gain(CONV_CH)
        p[pre + "conv_ln_b"] = nrm((CONV_CH,), 0.02)
    else:
        p[pre + "w_in"] = nrm((D, ODD_COLS), D ** -0.5)
        p[pre + "gqa_q_gain"] = gain(HEAD_DIM)
        p[pre + "gqa_k_gain"] = gain(HEAD_DIM)
        p[pre + "na_q_gain"] = gain(HEAD_DIM)
        p[pre + "na_k_gain"] = gain(HEAD_DIM)
        p[pre + "na_rpb"] = nrm((NA_HEADS, 2 * WIN_H - 1, 2 * WIN_W - 1), 0.1)
    p[pre + "w_out"] = nrm((MIX_OUT, D), MIX_OUT ** -0.5)
    p[pre + "ffn2_norm"] = gain(D)
    p[pre + "ffn2_w_in"] = nrm((D, 2 * D_FF), D ** -0.5)
    p[pre + "ffn2_w_out"] = nrm((D_FF, D), D_FF ** -0.5)
    return p


def setup_inputs(seed: int = 0) -> dict:
    key = jax.random.key(seed)
    k_x, k_c, k_ctx, k_cc, k_layers = jax.random.split(key, 5)
    inputs = {
        "x": jax.random.normal(k_x, (BATCH, SEQ, D_MODEL), jnp.float32),
        "c": jax.random.normal(k_c, (BATCH, D_MODEL), jnp.float32),
        "ctx": jax.random.normal(k_ctx, (BATCH, CTX_LEN, D_MODEL), jnp.float32),
        "c_ctx": jax.random.normal(k_cc, (D_MODEL,), jnp.float32),
    }
    layer_keys = jax.random.split(k_layers, DEPTH)
    for i in range(DEPTH):
        inputs.update(_layer_params(layer_keys[i], i))
    return inputs


def reference(x, c, ctx, c_ctx,
              l0_mod_w, l0_mod_b, l0_ffn1_norm, l0_ffn1_w_in, l0_ffn1_w_out, l0_mix_norm, l0_w_in,
              l0_mla_q_norm, l0_mla_w_uq, l0_mla_kv_norm, l0_mla_w_ukv, l0_mla_q_gain, l0_mla_k_gain,
              l0_conv_glu_b, l0_conv_dw_w, l0_conv_dw_b, l0_conv_ln_g, l0_conv_ln_b,
              l0_w_out, l0_ffn2_norm, l0_ffn2_w_in, l0_ffn2_w_out,
              l1_mod_w, l1_mod_b, l1_ffn1_norm, l1_ffn1_w_in, l1_ffn1_w_out, l1_mix_norm, l1_w_in,
              l1_gqa_q_gain, l1_gqa_k_gain, l1_na_q_gain, l1_na_k_gain, l1_na_rpb,
              l1_w_out, l1_ffn2_norm, l1_ffn2_w_in, l1_ffn2_w_out):
    layers = (
        dict(mod_w=l0_mod_w, mod_b=l0_mod_b, ffn1_norm=l0_ffn1_norm, ffn1_w_in=l0_ffn1_w_in,
             ffn1_w_out=l0_ffn1_w_out, mix_norm=l0_mix_norm, w_in=l0_w_in,
             mla_q_norm=l0_mla_q_norm, mla_w_uq=l0_mla_w_uq, mla_kv_norm=l0_mla_kv_norm,
             mla_w_ukv=l0_mla_w_ukv, mla_q_gain=l0_mla_q_gain, mla_k_gain=l0_mla_k_gain,
             conv_glu_b=l0_conv_glu_b, conv_dw_w=l0_conv_dw_w, conv_dw_b=l0_conv_dw_b,
             conv_ln_g=l0_conv_ln_g, conv_ln_b=l0_conv_ln_b, w_out=l0_w_out,
             ffn2_norm=l0_ffn2_norm, ffn2_w_in=l0_ffn2_w_in, ffn2_w_out=l0_ffn2_w_out),
        dict(mod_w=l1_mod_w, mod_b=l1_mod_b, ffn1_norm=l1_ffn1_norm, ffn1_w_in=l1_ffn1_w_in,
             ffn1_w_out=l1_ffn1_w_out, mix_norm=l1_mix_norm, w_in=l1_w_in,
             gqa_q_gain=l1_gqa_q_gain, gqa_k_gain=l1_gqa_k_gain, na_q_gain=l1_na_q_gain,
             na_k_gain=l1_na_k_gain, na_rpb=l1_na_rpb, w_out=l1_w_out,
             ffn2_norm=l1_ffn2_norm, ffn2_w_in=l1_ffn2_w_in, ffn2_w_out=l1_ffn2_w_out),
    )
    S = x.shape[1]
    ropes = (axial_rope_table(S, MLA_ROPE), axial_rope_table(S, HEAD_DIM))
    xl, xc = x, ctx
    for i in range(DEPTH):
        xl, xc = trunk_layer(xl, xc, c, c_ctx, layers[i], even=(i % 2 == 0),
                             ctx_out=(i < DEPTH - 1), ropes=ropes)
    return xl
```

```cpp
#include <hip/hip_runtime.h>
#include <hip/hip_cooperative_groups.h>
#include <cstdio>
#include <cstdint>
namespace cg = cooperative_groups;

#ifndef ONE_LAUNCH
#define ONE_LAUNCH 1
#endif

#define LAS __attribute__((address_space(3)))
#define GAS __attribute__((address_space(1)))
typedef unsigned short bf16_t;
typedef short bf16x8 __attribute__((ext_vector_type(8)));
typedef float f32x4 __attribute__((ext_vector_type(4)));
typedef float f32x16 __attribute__((ext_vector_type(16)));
typedef unsigned u32x2 __attribute__((ext_vector_type(2)));
typedef unsigned u32x4 __attribute__((ext_vector_type(4)));
typedef float f32x2_t __attribute__((ext_vector_type(2)));
typedef __bf16 bf16x2_t __attribute__((ext_vector_type(2)));

__device__ __forceinline__ unsigned pk2(float lo, float hi) { f32x2_t v = {lo, hi}; bf16x2_t b = __builtin_convertvector(v, bf16x2_t); return __builtin_bit_cast(unsigned, b); }
__device__ __forceinline__ float bflo(unsigned w) { return __uint_as_float(w << 16); }
__device__ __forceinline__ float bfhi(unsigned w) { return __uint_as_float(w & 0xffff0000u); }
__device__ __forceinline__ float wave_sum(float v) {
#pragma unroll
    for (int o = 1; o < 64; o <<= 1) v += __shfl_xor(v, o);
    return v;
}

__device__ __forceinline__ int lane_opaque() { unsigned m1 = ~0u; asm volatile("" : "+s"(m1)); int l = (int)__builtin_amdgcn_mbcnt_hi(m1, __builtin_amdgcn_mbcnt_lo(m1, 0u)); asm volatile("" : "+v"(l)); return l; }
constexpr int TL = 32768, TC = 2048, TA = TL + TC, DM = 1024, FF = 2816, NMODC = 9216;
constexpr int KVB = 4352;
constexpr float EPS = 1e-6f;
constexpr float LOG2E = 1.4426950408889634f;
__device__ __forceinline__ int kvrow_of(int row) { return row < TL ? (row >> 12) * KVB + 256 + (row & 4095) : ((row - TL) >> 8) * KVB + ((row - TL) & 255); }

constexpr size_t MiB = 1u << 20;
constexpr size_t WS_SSQ = 0;
constexpr size_t WS_BAR = 384 * 1024;
constexpr size_t WS_MODS = 512 * 1024;
constexpr size_t WS_ROPE64 = 2 * MiB;
constexpr size_t WS_ROPE32 = 3 * MiB;
constexpr size_t WS_W = 4 * MiB;
constexpr size_t WS_X = 84 * MiB;
constexpr size_t WS_H = 220 * MiB;
constexpr size_t WS_BIG = 288 * MiB;
constexpr size_t E_FIN = (size_t)5632 * 1024, E_FOUT = (size_t)1024 * 2816;
constexpr size_t W_F1I0 = 0, W_F1O0 = W_F1I0 + E_FIN, W_WIN0 = W_F1O0 + E_FOUT, W_UQ = W_WIN0 + (size_t)1792 * 1024, W_UKV = W_UQ + (size_t)768 * 384,
                 W_WO0 = W_UKV + (size_t)1024 * 256, W_F2I0 = W_WO0 + (size_t)1024 * 1024, W_F2O0 = W_F2I0 + E_FIN,
                 W_F1I1 = W_F2O0 + E_FOUT, W_F1O1 = W_F1I1 + E_FIN, W_WIN1 = W_F1O1 + E_FOUT, W_WO1 = W_WIN1 + (size_t)2304 * 1024,
                 W_F2I1 = W_WO1 + (size_t)1024 * 1024, W_F2O1 = W_F2I1 + E_FIN, W_END = W_F2O1 + E_FOUT;
static_assert(W_END * 2 <= 80 * MiB, "weights fit");
constexpr size_t B0_CKV = 0, B0_CQ = 17 * MiB, B0_Y = B0_CQ + 26 * MiB, B0_Q = B0_Y + 34 * MiB, B0_K = B0_Q + 51 * MiB, B0_V = B0_K + 51 * MiB;
constexpr size_t B1_QG = 0, B1_QN = 34 * MiB, B1_KG = 68 * MiB, B1_VG = 77 * MiB, B1_KN = 86 * MiB, B1_VN = 120 * MiB;
constexpr int LDS_BYTES = 135168;

namespace pg8 {
constexpr int BM = 256, BK = 64, HALF = 128, HTB = HALF * BK * 2, STAGE_BYTES = 8 * HTB, NXCD = 8, WGM = 8;
__host__ __device__ __forceinline__ int lds_byte(int r, int c) { const int st = (r >> 4) * 2 + (c >> 5), rr = r & 15, cc = c & 31, ob = rr * 64 + cc * 2; return st * 1024 + (ob ^ (((ob >> 9) & 1) << 5)); }
__host__ __device__ __forceinline__ void stage_rc(int b, int& R, int& C) { const int st = b / 1024, sb = b % 1024, swz = sb ^ (((sb >> 9) & 1) << 5); R = (st >> 1) * 16 + swz / 64; C = (st & 1) * 32 + (swz % 64) / 2; }
struct Unit { int pm, pn, k0, nt, split; };
struct Gemm { const bf16_t* A; const bf16_t* Bt; int M, N, K, lda; };
struct StaticOrder {
    int nM, nN, nwg, G, c, ntK, nsub;
    __device__ void init(int M, int N, int K, int G_, int c_, int sub_rows = 0) { nM = M / BM; nN = N / BM; nwg = nM * nN; G = G_; c = c_; ntK = K / BK; nsub = (sub_rows / BM) * nN * 4; }
    __device__ __forceinline__ bool next(int i, Unit& u) const {
        const long L = (long)i * G + c; const bool ok = L < nwg + nsub;
        int pm = 0, pn = 0, k0 = 0, nt = ntK, split = 0;
        if (L >= nwg) {
            const int j = (int)L - nwg, ks = j & 3, tile = j >> 2;
            pn = tile % nN; pm = nM + tile / nN; split = 1 + ks;
            const int nt44 = ks < 2 ? 12 : 10, k44 = ks < 2 ? 12 * ks : 24 + 10 * (ks - 2), ntg = ntK >> 2;
            nt = ntK == 44 ? nt44 : ntg; k0 = ntK == 44 ? k44 : ks * ntg;
        } else {
            int wgid = (int)L; { const int q = nwg / NXCD, r = nwg % NXCD, xcd = wgid % NXCD, off = wgid / NXCD; wgid = (xcd < r ? xcd * (q + 1) : r * (q + 1) + (xcd - r) * q) + off; }
            const int nig = WGM * nN, gid = wgid / nig, fm = gid * WGM, gsz = (nM - fm) < WGM ? (nM - fm) : WGM;
            pm = fm + ((wgid % nig) % gsz); pn = (wgid % nig) / gsz;
        }
        u.pm = pm; u.pn = pn; u.k0 = k0; u.nt = nt; u.split = split;
        return ok;
    }
};
template <class Epi>
__device__ __forceinline__ void gemm_phase(LAS unsigned char* lds, const Gemm g, const StaticOrder& S, const Epi& E, int wave_s) {
    const int lane = lane_opaque(), wid = wave_s, tid = wid * 64 + lane, wr = wid >> 2, wc = wid & 3, fr = lane & 15, fq = lane >> 4;
    const int K = g.K, lda = g.lda;
    unsigned voffA[2], voffB[2];
#pragma unroll
    for (int i = 0; i < 2; ++i) { int R, C; stage_rc(tid * 16 + i * 8192, R, C); voffA[i] = (unsigned)(R * lda + C) * 2u; voffB[i] = (unsigned)(R * K + C) * 2u; }
    const size_t kstep = (size_t)(BK * 2);
    const size_t hstepA = (size_t)HALF * lda * 2, hstepB = (size_t)HALF * K * 2;
    const size_t tstepA = 2 * hstepA, tstepB = 2 * hstepB;
    const unsigned ldsw = (unsigned)wid * 1024u;
    const int aoff = lds_byte(wr * 64 + fr, fq * 8), boff = lds_byte(wc * 32 + fr, fq * 8);
#define PG8_SA(b, h) (((b) * 2 + (h)) * HTB)
#define PG8_SB(b, h) ((4 + (b) * 2 + (h)) * HTB)
#define PG8_STAGE(bufoff, gbase, voff) do { _Pragma("unroll") for (int _i = 0; _i < 2; ++_i) \
        __builtin_amdgcn_global_load_lds((const unsigned*)((const char*)(gbase) + (voff)[_i]), (LAS unsigned*)(lds + (bufoff) + ldsw + _i * 8192), 16, 0, 0); } while (0)
#define PG8_LDA(dst, b, h) do { _Pragma("unroll") for (int m = 0; m < 4; ++m) _Pragma("unroll") for (int k = 0; k < 2; ++k) dst[m][k] = *(const LAS bf16x8*)(lds + PG8_SA(b, h) + aoff + m * 2048 + k * 1024); } while (0)
#define PG8_LDB(dst, b, h) do { _Pragma("unroll") for (int n = 0; n < 2; ++n) _Pragma("unroll") for (int k = 0; k < 2; ++k) dst[n][k] = *(const LAS bf16x8*)(lds + PG8_SB(b, h) + boff + n * 2048 + k * 1024); } while (0)
#define PG8_MMA(ai, bj, At, Bt) do { __builtin_amdgcn_s_setprio(1); _Pragma("unroll") for (int m = 0; m < 4; ++m) _Pragma("unroll") for (int n = 0; n < 2; ++n) _Pragma("unroll") for (int k = 0; k < 2; ++k) \
        acc[ai][bj][m][n] = __builtin_amdgcn_mfma_f32_16x16x32_bf16(Bt[n][k], At[m][k], acc[ai][bj][m][n], 0, 0, 0); __builtin_amdgcn_s_setprio(0); } while (0)
#define PG8_WAIT_V(n) asm volatile("s_waitcnt vmcnt(" #n ")" ::: "memory")
#define PG8_WAIT_L(n) asm volatile("s_waitcnt lgkmcnt(" #n ")" ::: "memory")
#define PG8_BAR __builtin_amdgcn_s_barrier()
#define PG8_SCHED __builtin_amdgcn_sched_barrier(0)
    Unit cur, nxt; int ui = 0;
    if (!S.next(0, cur)) return;
    f32x4 acc[2][2][4][2];
#pragma unroll
    for (int a = 0; a < 2; ++a)
#pragma unroll
        for (int b = 0; b < 2; ++b)
#pragma unroll
            for (int m = 0; m < 4; ++m)
#pragma unroll
                for (int n = 0; n < 2; ++n) acc[a][b][m][n] = (f32x4){0.f, 0.f, 0.f, 0.f};
    bf16x8 At[4][2], B0[2][2], B1[2][2];
    const char* cA = (const char*)g.A + (size_t)cur.pm * tstepA + (size_t)cur.k0 * kstep; const char* cB = (const char*)g.Bt + (size_t)cur.pn * tstepB + (size_t)cur.k0 * kstep;
    PG8_STAGE(PG8_SB(0, 0), cB, voffB); PG8_STAGE(PG8_SB(0, 1), cB + hstepB, voffB); PG8_STAGE(PG8_SA(0, 0), cA, voffA); PG8_STAGE(PG8_SA(0, 1), cA + hstepA, voffA);
    if (wr == 1) PG8_BAR;
    PG8_WAIT_V(2); PG8_BAR;
    PG8_STAGE(PG8_SB(1, 0), cB + kstep, voffB); PG8_STAGE(PG8_SA(1, 0), cA + kstep, voffA); PG8_STAGE(PG8_SB(1, 1), cB + hstepB + kstep, voffB);
    PG8_WAIT_V(6); PG8_BAR;
    for (;;) {
        const bool has_next = S.next(ui + 1, nxt);
        const char* nA = has_next ? (const char*)g.A + (size_t)nxt.pm * tstepA + (size_t)nxt.k0 * kstep : cA; const char* nB = has_next ? (const char*)g.Bt + (size_t)nxt.pn * tstepB + (size_t)nxt.k0 * kstep : cB;
        const int nt = cur.nt;
        for (int t = 0; t < nt; t += 2) {
            const bool last = (t == nt - 2);
            const char* a1 = cA + (size_t)(t + 1) * kstep;
            const char* a2 = last ? nA : cA + (size_t)(t + 2) * kstep; const char* b2 = last ? nB : cB + (size_t)(t + 2) * kstep;
            const char* a3 = a2 + kstep; const char* b3 = b2 + kstep;
            PG8_LDB(B0, 0, 0); PG8_LDB(B1, 0, 1); PG8_SCHED; PG8_LDA(At, 0, 0); PG8_STAGE(PG8_SA(1, 1), a1 + hstepA, voffA);
            PG8_WAIT_V(8); PG8_WAIT_L(0); PG8_BAR; PG8_MMA(0, 0, At, B0); PG8_MMA(0, 1, At, B1); PG8_BAR; PG8_SCHED;
            PG8_LDA(At, 0, 1); PG8_STAGE(PG8_SB(0, 0), b2, voffB); PG8_STAGE(PG8_SB(0, 1), b2 + hstepB, voffB); PG8_STAGE(PG8_SA(0, 0), a2, voffA);
            PG8_WAIT_V(8); PG8_WAIT_L(0); PG8_BAR; PG8_MMA(1, 0, At, B0); PG8_MMA(1, 1, At, B1); PG8_BAR; PG8_SCHED;
            PG8_LDB(B0, 1, 0); PG8_LDB(B1, 1, 1); PG8_SCHED; PG8_LDA(At, 1, 0); PG8_STAGE(PG8_SA(0, 1), a2 + hstepA, voffA);
            PG8_WAIT_V(8); PG8_WAIT_L(0); PG8_BAR; PG8_MMA(0, 0, At, B0); PG8_MMA(0, 1, At, B1); PG8_BAR; PG8_SCHED;
            PG8_LDA(At, 1, 1); PG8_STAGE(PG8_SB(1, 0), b3, voffB); PG8_STAGE(PG8_SB(1, 1), b3 + hstepB, voffB); PG8_STAGE(PG8_SA(1, 0), a3, voffA);
            PG8_WAIT_V(8); PG8_WAIT_L(0); PG8_BAR; PG8_MMA(1, 0, At, B0); PG8_MMA(1, 1, At, B1); PG8_BAR; PG8_SCHED;
        }
        if (wr == 0) PG8_BAR;
        { const int l2 = lane_opaque(); E(acc, cur, wr, wc, l2 & 15, l2 >> 4); }
        if (!has_next) break;
#pragma unroll
        for (int a = 0; a < 2; ++a)
#pragma unroll
            for (int b = 0; b < 2; ++b)
#pragma unroll
                for (int m = 0; m < 4; ++m)
#pragma unroll
                    for (int n = 0; n < 2; ++n) acc[a][b][m][n] = (f32x4){0.f, 0.f, 0.f, 0.f};
        cur = nxt; cA = nA; cB = nB; ++ui;
        if (wr == 1) PG8_BAR;
    }
    PG8_WAIT_V(0);
    PG8_BAR;
#undef PG8_SA
#undef PG8_SB
#undef PG8_STAGE
#undef PG8_LDA
#undef PG8_LDB
#undef PG8_MMA
#undef PG8_WAIT_V
#undef PG8_WAIT_L
#undef PG8_BAR
#undef PG8_SCHED
}
}
using pg8::Unit;
typedef f32x4 AccT[2][2][4][2];

__device__ __forceinline__ void st_bf4(bf16_t* p, f32x4 v) { u32x2 w; w.x = pk2(v[0], v[1]); w.y = pk2(v[2], v[3]); *(GAS u32x2*)p = w; }
__device__ __forceinline__ float dot4(f32x4 v) { return (v[0] * v[0] + v[1] * v[1]) + (v[2] * v[2] + v[3] * v[3]); }
__device__ __forceinline__ float fq_sum(float s) { s += __shfl_xor(s, 16); s += __shfl_xor(s, 32); return s; }
__device__ __forceinline__ f32x4 rope4(f32x4 v, const float2* tab) {
    const float2 a = tab[0], b = tab[1];
    return (f32x4){v[0] * a.x - v[1] * a.y, v[0] * a.y + v[1] * a.x, v[2] * b.x - v[3] * b.y, v[2] * b.y + v[3] * b.x};
}
__device__ __forceinline__ float sigmoidf_(float x) { return __builtin_amdgcn_rcpf(1.f + __expf(-x)); }

struct EpiSwiglu {
    bf16_t* hid;
    __device__ __forceinline__ void operator()(const AccT& acc, const Unit& u, int wr, int wc, int fr, int fq) const {
#pragma unroll
        for (int ai = 0; ai < 2; ++ai)
#pragma unroll
            for (int m = 0; m < 4; ++m) {
                const int row = u.pm * 256 + ai * 128 + wr * 64 + m * 16 + fr;
                bf16_t* rp = hid + (size_t)row * FF + u.pn * 128 + wc * 32 + fq * 8;
                u32x4 w;
#pragma unroll
                for (int n = 0; n < 2; ++n) { const f32x4 g = acc[ai][0][m][n], uu = acc[ai][1][m][n]; f32x4 h;
#pragma unroll
                    for (int j = 0; j < 4; ++j) h[j] = g[j] * sigmoidf_(g[j]) * uu[j];
                    if (n == 0) { w.x = pk2(h[0], h[1]); w.y = pk2(h[2], h[3]); } else { w.z = pk2(h[0], h[1]); w.w = pk2(h[2], h[3]); } }
                *(GAS u32x4*)rp = w;
            }
    }
};
struct EpiResid {
    const float* xin_lat; const float* xin_ctx; float* out; const float* gate; float* part; float gmul;
    __device__ __forceinline__ void operator()(const AccT& acc, const Unit& u, int wr, int wc, int fr, int fq) const {
        const int r0 = u.pm * 256; const int mi = r0 < TL ? (r0 >> 12) : 8;
        const int cb = u.pn * 256 + wc * 32 + fq * 4;
        const float* gp = gate + (size_t)mi * NMODC + cb;
        f32x4 gv[2][2];
#pragma unroll
        for (int bj = 0; bj < 2; ++bj)
#pragma unroll
            for (int n = 0; n < 2; ++n) gv[bj][n] = *(const GAS f32x4*)(gp + bj * 128 + n * 16) * gmul;
        if (u.split) {
#pragma unroll
            for (int ai = 0; ai < 2; ++ai)
#pragma unroll
                for (int m = 0; m < 4; ++m) { const int row = r0 + ai * 128 + wr * 64 + m * 16 + fr;
#pragma unroll
                    for (int bj = 0; bj < 2; ++bj)
#pragma unroll
                        for (int n = 0; n < 2; ++n) *(GAS f32x4*)(part + ((size_t)(u.split - 1) * TC + (row - TL)) * DM + cb + bj * 128 + n * 16) = gv[bj][n] * acc[ai][bj][m][n]; }
        } else {
#pragma unroll
            for (int ai = 0; ai < 2; ++ai) {
                f32x4 xv[4][2][2];
#pragma unroll
                for (int m = 0; m < 4; ++m) { const int row = r0 + ai * 128 + wr * 64 + m * 16 + fr;
                    const float* xp = (row < TL ? xin_lat + (size_t)row * DM : xin_ctx + (size_t)(row - TL) * DM) + cb;
#pragma unroll
                    for (int bj = 0; bj < 2; ++bj)
#pragma unroll
                        for (int n = 0; n < 2; ++n) xv[m][bj][n] = *(const GAS f32x4*)(xp + bj * 128 + n * 16); }
                asm volatile("" ::: "memory");
#pragma unroll
                for (int m = 0; m < 4; ++m) { const int row = r0 + ai * 128 + wr * 64 + m * 16 + fr;
                    float* op = out + (size_t)row * DM + cb;
#pragma unroll
                    for (int bj = 0; bj < 2; ++bj)
#pragma unroll
                        for (int n = 0; n < 2; ++n) *(GAS f32x4*)(op + bj * 128 + n * 16) = xv[m][bj][n] + gv[bj][n] * acc[ai][bj][m][n]; }
                asm volatile("" ::: "memory");
            }
        }
    }
};
struct EpiWin0 {
    bf16_t *ckv, *cq, *y, *k0; float *ssq_kv, *ssq_q; const float* glu_b; const float* k_gain; const float2* rope32;
    __device__ __forceinline__ void operator()(const AccT& acc, const Unit& u, int wr, int wc, int fr, int fq) const {
        const int pn = u.pn; const int rbase = u.pm * 256 + wr * 64 + fr;
        if (pn < 2) {
            bf16_t* base = pn == 0 ? ckv : cq; const int pitch = pn == 0 ? 256 : 384; float* sq = pn == 0 ? ssq_kv : ssq_q;
#pragma unroll
            for (int ai = 0; ai < 2; ++ai)
#pragma unroll
                for (int m = 0; m < 4; ++m) {
                    const int row = rbase + ai * 128 + m * 16;
                    float ss = 0.f; bf16_t* p = base + (size_t)row * pitch + wc * 32 + fq * 4;
#pragma unroll
                    for (int bj = 0; bj < 2; ++bj)
#pragma unroll
                        for (int n = 0; n < 2; ++n) { const f32x4 v = acc[ai][bj][m][n]; ss += dot4(v); st_bf4(p + bj * 128 + n * 16, v); }
                    ss = fq_sum(ss); if (fq == 0) atomicAdd(sq + row, ss);
                    asm volatile("" ::: "memory");
                }
        } else if (pn == 2) {
#pragma unroll
            for (int ai = 0; ai < 2; ++ai)
#pragma unroll
                for (int m = 0; m < 4; ++m) {
                    const int row = rbase + ai * 128 + m * 16;
                    float ss = 0.f; bf16_t* p = cq + (size_t)row * 384 + 256 + wc * 32 + fq * 4;
#pragma unroll
                    for (int n = 0; n < 2; ++n) { const f32x4 v = acc[ai][0][m][n]; ss += dot4(v); st_bf4(p + n * 16, v); }
                    ss = fq_sum(ss); if (fq == 0) atomicAdd(ssq_q + row, ss);
                    if (wc == 0) {
                        float s2 = dot4(acc[ai][1][m][0]) + dot4(acc[ai][1][m][1]); s2 = fq_sum(s2);
                        const float r2 = __builtin_amdgcn_rsqf(s2 * (1.f / 32.f) + EPS);
                        const int kvr = kvrow_of(row);
#pragma unroll
                        for (int n = 0; n < 2; ++n) { const int dd = n * 16 + fq * 4; f32x4 v = acc[ai][1][m][n] * r2 * *(const f32x4*)(k_gain + 64 + dd);
                            if (row < TL) v = rope4(v, rope32 + (size_t)(row & 4095) * 16 + (dd >> 1));
                            bf16_t* kp = k0 + (size_t)kvr * 768 + 64 + dd;
#pragma unroll
                            for (int h = 0; h < 8; ++h) st_bf4(kp + h * 96, v); }
                    }
                    asm volatile("" ::: "memory");
                }
        } else {
            const int cch = (pn - 3) * 128 + wc * 32 + fq * 4;
#pragma unroll
            for (int n = 0; n < 2; ++n) {
                const f32x4 ba = *(const f32x4*)(glu_b + cch + n * 16), bg = *(const f32x4*)(glu_b + 512 + cch + n * 16);
#pragma unroll
                for (int ai = 0; ai < 2; ++ai)
#pragma unroll
                    for (int m = 0; m < 4; ++m) {
                        const int row = rbase + ai * 128 + m * 16;
                        const f32x4 a = acc[ai][0][m][n] + ba, g = acc[ai][1][m][n] + bg; f32x4 o;
#pragma unroll
                        for (int j = 0; j < 4; ++j) o[j] = a[j] * sigmoidf_(g[j]);
                        st_bf4(y + (size_t)row * 512 + cch + n * 16, o);
                        asm volatile("" ::: "memory");
                    }
            }
        }
    }
};
struct EpiQup {
    const float* ssq_q; const float* q_gain; const float2* rope32; bf16_t* q0; float qscale;
    __device__ __forceinline__ void operator()(const AccT& acc, const Unit& u, int wr, int wc, int fr, int fq) const {
        const int pn = u.pn; const int rbase = u.pm * 256 + wr * 64 + fr;
        if (pn < 2) {
            const int h = pn * 4 + wc;
#pragma unroll
            for (int ai = 0; ai < 2; ++ai)
#pragma unroll
                for (int m = 0; m < 4; ++m) {
                    const int row = rbase + ai * 128 + m * 16;
                    const float rr = __builtin_amdgcn_rsqf(ssq_q[row] * (1.f / 384.f) + EPS);
                    float ss = 0.f;
#pragma unroll
                    for (int bj = 0; bj < 2; ++bj)
#pragma unroll
                        for (int n = 0; n < 2; ++n) ss += dot4(acc[ai][bj][m][n]);
                    ss = fq_sum(ss) * rr * rr;
                    const float r2 = __builtin_amdgcn_rsqf(ss * (1.f / 64.f) + EPS) * rr * qscale;
                    bf16_t* p = q0 + (size_t)row * 768 + h * 96 + fq * 4;
#pragma unroll
                    for (int bj = 0; bj < 2; ++bj)
#pragma unroll
                        for (int n = 0; n < 2; ++n) { const int dim = bj * 32 + n * 16 + fq * 4; st_bf4(p + bj * 32 + n * 16, acc[ai][bj][m][n] * r2 * *(const f32x4*)(q_gain + dim)); }
                    asm volatile("" ::: "memory");
                }
        } else {
#pragma unroll
            for (int ai = 0; ai < 2; ++ai)
#pragma unroll
                for (int m = 0; m < 4; ++m) {
                    const int row = rbase + ai * 128 + m * 16;
                    const float rr = __builtin_amdgcn_rsqf(ssq_q[row] * (1.f / 384.f) + EPS);
#pragma unroll
                    for (int bj = 0; bj < 2; ++bj) {
                        const int h = 2 * wc + bj;
                        float ss = dot4(acc[ai][bj][m][0]) + dot4(acc[ai][bj][m][1]); ss = fq_sum(ss) * rr * rr;
                        const float r2 = __builtin_amdgcn_rsqf(ss * (1.f / 32.f) + EPS) * rr;
#pragma unroll
                        for (int n = 0; n < 2; ++n) { const int dd = n * 16 + fq * 4; f32x4 v = acc[ai][bj][m][n] * r2 * *(const f32x4*)(q_gain + 64 + dd);
                            if (row < TL) v = rope4(v, rope32 + (size_t)(row & 4095) * 16 + (dd >> 1));
                            st_bf4(q0 + (size_t)row * 768 + h * 96 + 64 + dd, v * qscale); }
                    }
                    asm volatile("" ::: "memory");
                }
        }
    }
};
struct EpiKvup {
    const float* ssq_kv; const float* k_gain; bf16_t* k0; bf16_t* v0;
    __device__ __forceinline__ void operator()(const AccT& acc, const Unit& u, int wr, int wc, int fr, int fq) const {
        const int pn = u.pn; const int rbase = u.pm * 256 + wr * 64 + fr;
        if (pn < 2) {
            const int h = pn * 4 + wc;
#pragma unroll
            for (int ai = 0; ai < 2; ++ai)
#pragma unroll
                for (int m = 0; m < 4; ++m) {
                    const int row = rbase + ai * 128 + m * 16;
                    const float rr = __builtin_amdgcn_rsqf(ssq_kv[row] * (1.f / 256.f) + EPS);
                    const int kvr = kvrow_of(row);
                    float ss = 0.f;
#pragma unroll
                    for (int bj = 0; bj < 2; ++bj)
#pragma unroll
                        for (int n = 0; n < 2; ++n) ss += dot4(acc[ai][bj][m][n]);
                    ss = fq_sum(ss) * rr * rr;
                    const float r2 = __builtin_amdgcn_rsqf(ss * (1.f / 64.f) + EPS) * rr;
                    bf16_t* p = k0 + (size_t)kvr * 768 + h * 96 + fq * 4;
#pragma unroll
                    for (int bj = 0; bj < 2; ++bj)
#pragma unroll
                        for (int n = 0; n < 2; ++n) { const int dim = bj * 32 + n * 16 + fq * 4; st_bf4(p + bj * 32 + n * 16, acc[ai][bj][m][n] * r2 * *(const f32x4*)(k_gain + dim)); }
                    asm volatile("" ::: "memory");
                }
        } else {
            const int h = (pn - 2) * 4 + wc;
#pragma unroll
            for (int ai = 0; ai < 2; ++ai)
#pragma unroll
                for (int m = 0; m < 4; ++m) {
                    const int row = rbase + ai * 128 + m * 16;
                    const float rr = __builtin_amdgcn_rsqf(ssq_kv[row] * (1.f / 256.f) + EPS);
                    bf16_t* p = v0 + (size_t)kvrow_of(row) * 512 + h * 64 + fq * 4;
#pragma unroll
                    for (int bj = 0; bj < 2; ++bj)
#pragma unroll
                        for (int n = 0; n < 2; ++n) st_bf4(p + bj * 32 + n * 16, acc[ai][bj][m][n] * rr);
                    asm volatile("" ::: "memory");
                }
        }
    }
};
struct EpiWin1 {
    bf16_t *qg, *qn, *kg, *vg, *kn, *vn; const float *gq_gain, *gk_gain, *nq_gain, *nk_gain; const float2* rope64; float qscale;
    __device__ __forceinline__ void operator()(const AccT& acc, const Unit& u, int wr, int wc, int fr, int fq) const {
        const int s = u.pn * 4 + wc;
        bf16_t* dst; int pitch; bool kvsel, rope; const float* gain; float sc = 1.f;
        if (s < 2)       { dst = kg + s * 64;        pitch = 128; kvsel = true;  rope = true;  gain = gk_gain; }
        else if (s < 4)  { dst = vg + (s - 2) * 64;  pitch = 128; kvsel = true;  rope = false; gain = nullptr; }
        else if (s < 12) { dst = kn + (s - 4) * 64;  pitch = 512; kvsel = true;  rope = false; gain = nk_gain; }
        else if (s < 20) { dst = vn + (s - 12) * 64; pitch = 512; kvsel = true;  rope = false; gain = nullptr; }
        else if (s < 28) { dst = qg + (s - 20) * 64; pitch = 512; kvsel = false; rope = true;  gain = gq_gain; sc = qscale; }
        else             { dst = qn + (s - 28) * 64; pitch = 512; kvsel = false; rope = false; gain = nq_gain; sc = qscale; }
#pragma unroll
        for (int ai = 0; ai < 2; ++ai)
#pragma unroll
            for (int m = 0; m < 4; ++m) {
                const int row = u.pm * 256 + ai * 128 + wr * 64 + m * 16 + fr;
                const int drow = kvsel ? kvrow_of(row) : row;
                float r2 = 1.f;
                if (gain) { float ss = 0.f;
#pragma unroll
                    for (int bj = 0; bj < 2; ++bj)
#pragma unroll
                        for (int n = 0; n < 2; ++n) ss += dot4(acc[ai][bj][m][n]);
                    ss = fq_sum(ss); r2 = __builtin_amdgcn_rsqf(ss * (1.f / 64.f) + EPS); }
                bf16_t* p = dst + (size_t)drow * pitch + fq * 4;
#pragma unroll
                for (int bj = 0; bj < 2; ++bj)
#pragma unroll
                    for (int n = 0; n < 2; ++n) { const int dim = bj * 32 + n * 16 + fq * 4; f32x4 v = acc[ai][bj][m][n] * r2;
                        if (gain) v = v * *(const f32x4*)(gain + dim);
                        if (rope && row < TL) v = rope4(v, rope64 + (size_t)(row & 4095) * 32 + (dim >> 1));
                        st_bf4(p + bj * 32 + n * 16, v * sc); }
                asm volatile("" ::: "memory");
            }
    }
};

__device__ __forceinline__ int crow(int r, int hi) { return (r & 3) + 8 * (r >> 2) + 4 * hi; }
typedef short v4i16_t __attribute__((ext_vector_type(4)));
__device__ __forceinline__ u32x2 vtr(const LAS unsigned char* p) { return __builtin_bit_cast(u32x2, __builtin_amdgcn_ds_read_tr16_b64_v4i16((LAS v4i16_t*)p)); }
__device__ __forceinline__ float max3f(float a, float b, float c) { float r; asm("v_max3_f32 %0, %1, %2, %3" : "=v"(r) : "v"(a), "v"(b), "v"(c)); return r; }
__device__ __forceinline__ float xhalf_max(float v) { auto rr = __builtin_amdgcn_permlane32_swap(__float_as_uint(v), __float_as_uint(v), false, false); return fmaxf(__uint_as_float(rr[0]), __uint_as_float(rr[1])); }
__device__ __forceinline__ float xhalf_sum(float v) { auto rr = __builtin_amdgcn_permlane32_swap(__float_as_uint(v), __float_as_uint(v), false, false); return __uint_as_float(rr[0]) + __uint_as_float(rr[1]); }
template <int DQK, bool NA>
__device__ __forceinline__ void attn_unit(LAS unsigned char* lds, const bf16_t* Qrow0, int qpitch, const bf16_t* Kb, int kpitch, const bf16_t* Vb, int vpitch,
                                          bf16_t* Orow0, int opitch, int ntiles, int rho0, int g4, const float* rpb_h, int wave_s) {
    constexpr int KP = DQK * 2 + 16, KBYTES = 128 * KP, VP = 192  , VBYTES = 128 * VP, CPR = DQK / 8, NKC = CPR / 4  , BUFB = KBYTES + VBYTES;
    const int lane = lane_opaque(), wid = wave_s, tid = wid * 64 + lane, r32 = lane & 31, hi = lane >> 5;
    bf16x8 qr[DQK / 16];
    { const bf16_t* qp = Qrow0 + (size_t)(wid * 32 + r32) * qpitch + hi * 8;
#pragma unroll
      for (int d0 = 0; d0 < DQK / 16; ++d0) qr[d0] = *(const GAS bf16x8*)(qp + d0 * 16); }
    const GAS bf16_t* Kg_ = (const GAS bf16_t*)Kb; const GAS bf16_t* Vg_ = (const GAS bf16_t*)Vb;
    const int nst = (ntiles + 1) >> 1;
    u32x4 kreg[NKC], vreg[2];
#define ATT_SROW(s) ((s) < 2 ? 128 * (s) : 128 * (s) + 64 * rho0)
#define ATT_LOAD(s) do { const int sr_ = ATT_SROW(s); \
        _Pragma("unroll") for (int i_ = 0; i_ < NKC; ++i_) { const int c_ = tid + 512 * i_; kreg[i_] = *(const GAS u32x4*)(Kg_ + (size_t)(sr_ + c_ / CPR) * kpitch + (c_ % CPR) * 8); } \
        _Pragma("unroll") for (int i_ = 0; i_ < 2; ++i_) { const int c_ = tid + 512 * i_; vreg[i_] = *(const GAS u32x4*)(Vg_ + (size_t)(sr_ + (c_ >> 3)) * vpitch + (c_ & 7) * 8); } } while (0)
#define ATT_STORE(b) do { LAS unsigned char* kb_ = lds + (b) * BUFB; \
        _Pragma("unroll") for (int i_ = 0; i_ < NKC; ++i_) { const int c_ = tid + 512 * i_; *(LAS u32x4*)(kb_ + (c_ / CPR) * KP + (c_ % CPR) * 16) = kreg[i_]; } \
        _Pragma("unroll") for (int i_ = 0; i_ < 2; ++i_) { const int c_ = tid + 512 * i_; *(LAS u32x4*)(kb_ + KBYTES + (c_ >> 3) * VP + (c_ & 7) * 16) = vreg[i_]; } } while (0)
    ATT_LOAD(0); ATT_STORE(0);
    __syncthreads();
    float m_run = 0.f, l_run = 0.f; f32x16 o0 = f32x16{}, o1 = f32x16{}, negm = f32x16{};
    bool first = true;
    const int r_w = g4 + (wid >> 1), rs = min(max(r_w - 4, 0), 56), cq_ = 32 * (wid & 1) + r32, cs = min(max(cq_ - 8, 0), 48);
    unsigned vmask = 0u; int bpbase = 0;
    if (NA) {
#pragma unroll
        for (int r = 0; r < 16; ++r) { const int ka_ = crow(r, hi), kc_ = ka_ + 32;
            vmask |= ((ka_ >= cs) && (ka_ < cs + 16) ? 1u : 0u) << r; vmask |= ((kc_ >= cs) && (kc_ < cs + 16) ? 1u : 0u) << (16 + r); }
        bpbase = (15 - cq_ + 4 * hi) * 4;
    }
    for (int s = 0; s < nst; ++s) {
        const int b = s & 1;
        if (s + 1 < nst) ATT_LOAD(s + 1);
#pragma unroll
        for (int sub = 0; sub < 2; ++sub) {
            const int t = 2 * s + sub;
            bool active = t < ntiles; int rho = 0;
            if (NA && t >= 4) { rho = rho0 + (t - 4); active = active && (rho >= rs) && (rho < rs + 8); }
            if (active) {
            float rowv = 0.f;
            if (NA && t >= 4) rowv = lane < 31 ? *(const GAS float*)(rpb_h + (rho - r_w + 7) * 31 + lane) * LOG2E : 0.f;
            const LAS unsigned char* kb = lds + b * BUFB + (sub * 64 + r32) * KP + hi * 16;
            f32x16 p0 = negm, p1 = negm;
            bf16x8 kf[DQK / 8];
#pragma unroll
            for (int d0 = 0; d0 < DQK / 16; ++d0) { kf[2 * d0] = *(const LAS bf16x8*)(kb + d0 * 32); kf[2 * d0 + 1] = *(const LAS bf16x8*)(kb + 32 * KP + d0 * 32); }
            __builtin_amdgcn_sched_barrier(0);
#pragma unroll
            for (int d0 = 0; d0 < DQK / 16; ++d0) {
                p0 = __builtin_amdgcn_mfma_f32_32x32x16_bf16(kf[2 * d0], qr[d0], p0, 0, 0, 0);
                p1 = __builtin_amdgcn_mfma_f32_32x32x16_bf16(kf[2 * d0 + 1], qr[d0], p1, 0, 0, 0);
            }
            const LAS unsigned char* vb = lds + b * BUFB + KBYTES + (sub * 64 + 4 * hi + ((lane & 15) >> 2)) * VP + (16 * ((lane >> 4) & 1) + 4 * (lane & 3)) * 2;
            u32x2 va0[4], va1[4], vc0[4], vc1[4];
#pragma unroll
            for (int j = 0; j < 4; ++j) { va0[j] = vtr(vb + (16 * j) * VP); va1[j] = vtr(vb + (16 * j + 8) * VP); vc0[j] = vtr(vb + (16 * j) * VP + 64); vc1[j] = vtr(vb + (16 * j + 8) * VP + 64); }
            __builtin_amdgcn_sched_barrier(0);
            if (NA && t >= 4) {
                const int rvi = __builtin_bit_cast(int, rowv);
#pragma unroll
                for (int r = 0; r < 16; ++r) {
                    const int o_ = 4 * ((r & 3) + 8 * (r >> 2));
                    const float ba = __builtin_bit_cast(float, __builtin_amdgcn_ds_bpermute(bpbase + o_, rvi)), bc = __builtin_bit_cast(float, __builtin_amdgcn_ds_bpermute(bpbase + o_ + 128, rvi));
                    p0[r] = ((vmask >> r) & 1u) ? p0[r] + ba : -1e30f; p1[r] = ((vmask >> (16 + r)) & 1u) ? p1[r] + bc : -1e30f;
                }
            }
            float mx = max3f(p0[0], p1[0], p0[1]), mx2 = max3f(p1[1], p0[2], p1[2]);
#pragma unroll
            for (int r = 3; r < 15; r += 2) { mx = max3f(mx, p0[r], p1[r]); mx2 = max3f(mx2, p0[r + 1], p1[r + 1]); }
            mx = xhalf_max(max3f(mx, mx2, max3f(p0[15], p1[15], p0[15])));
            if (first || __any(mx > 8.f)) {
                const float dl = first ? mx : fmaxf(mx, 0.f);
                m_run += dl;
                if (!first) { const float alpha = __builtin_amdgcn_exp2f(-dl); l_run *= alpha; o0 = o0 * alpha; o1 = o1 * alpha; }
#pragma unroll
                for (int r = 0; r < 16; ++r) { p0[r] -= dl; p1[r] -= dl; negm[r] = -m_run; }
                first = false;
            }
            float rsum = 0.f;
#pragma unroll
            for (int r = 0; r < 16; ++r) { p0[r] = __builtin_amdgcn_exp2f(p0[r]); p1[r] = __builtin_amdgcn_exp2f(p1[r]); rsum += p0[r] + p1[r]; }
            l_run += rsum;
            u32x4 pw[4];
#pragma unroll
            for (int j = 0; j < 2; ++j) {
                pw[j] = (u32x4){pk2(p0[8 * j], p0[8 * j + 1]), pk2(p0[8 * j + 2], p0[8 * j + 3]), pk2(p0[8 * j + 4], p0[8 * j + 5]), pk2(p0[8 * j + 6], p0[8 * j + 7])};
                pw[2 + j] = (u32x4){pk2(p1[8 * j], p1[8 * j + 1]), pk2(p1[8 * j + 2], p1[8 * j + 3]), pk2(p1[8 * j + 4], p1[8 * j + 5]), pk2(p1[8 * j + 6], p1[8 * j + 7])};
            }
#pragma unroll
            for (int j = 0; j < 4; ++j) {
                const u32x2 a0 = va0[j], a1 = va1[j], c0 = vc0[j], c1 = vc1[j];
                const bf16x8 pj = __builtin_bit_cast(bf16x8, pw[j]);
                o0 = __builtin_amdgcn_mfma_f32_32x32x16_bf16(__builtin_bit_cast(bf16x8, ((u32x4){a0.x, a0.y, a1.x, a1.y})), pj, o0, 0, 0, 0);
                o1 = __builtin_amdgcn_mfma_f32_32x32x16_bf16(__builtin_bit_cast(bf16x8, ((u32x4){c0.x, c0.y, c1.x, c1.y})), pj, o1, 0, 0, 0);
            }
            }
        }
        if (s + 1 < nst) ATT_STORE(b ^ 1);
        __syncthreads();
    }
    const float inv = __builtin_amdgcn_rcpf(xhalf_sum(l_run));
    bf16_t* op = Orow0 + (size_t)(wid * 32 + r32) * opitch + 4 * hi;
#pragma unroll
    for (int rg = 0; rg < 4; ++rg) {
        st_bf4(op + 8 * rg, (f32x4){o0[4 * rg], o0[4 * rg + 1], o0[4 * rg + 2], o0[4 * rg + 3]} * inv);
        st_bf4(op + 32 + 8 * rg, (f32x4){o1[4 * rg], o1[4 * rg + 1], o1[4 * rg + 2], o1[4 * rg + 3]} * inv);
    }
#undef ATT_SROW
#undef ATT_LOAD
#undef ATT_STORE
}

#define XB_TMO      128
#define XB_XCNT(j)  (256  + 64 * (j))
#define XB_XSUB(j)  (1280 + 64 * (j))
#define XB_XGEN(j)  (2304 + 64 * (j))
#define XB_TOP      3328
#define XB_TOPGEN   3392
#define XCD_BAR_WORDS 3456
#define XB_SPIN_CAP (1u << 18)

__device__ __forceinline__ unsigned xb_ld(unsigned* p)              { return __hip_atomic_load(p, __ATOMIC_RELAXED, __HIP_MEMORY_SCOPE_AGENT); }
__device__ __forceinline__ unsigned xb_add(unsigned* p, unsigned v) { return __hip_atomic_fetch_add(p, v, __ATOMIC_RELAXED, __HIP_MEMORY_SCOPE_AGENT); }
__device__ __forceinline__ unsigned xb_xcc_id() { return (unsigned)__builtin_amdgcn_s_getreg((3 << 11) | 20) & 0xFu; }
#define XB_SPIN(cond, bar) do { unsigned _sp = 0; while (cond) { __builtin_amdgcn_s_sleep(1); \
    if ((++_sp & 255u) == 0u) { if (xb_ld(&(bar)[XB_TMO])) break; if (_sp > XB_SPIN_CAP) { atomicAdd(&(bar)[XB_TMO], 1u); break; } } } } while (0)

struct XcdBarrier {
    unsigned* bar; unsigned x;
    volatile LAS unsigned* st;
};

__device__ __forceinline__ XcdBarrier xcd_barrier_post(unsigned* bar, volatile LAS unsigned* st) {
    XcdBarrier b; b.bar = bar; b.x = xb_xcc_id(); b.st = st;
    if (threadIdx.x == 0) (void)xb_add(&bar[XB_XCNT(b.x)], 1u);
    return b;
}
__device__ __forceinline__ void xcd_barrier_complete(unsigned* bar, unsigned x, unsigned& nloc, unsigned& nx) {
    const unsigned G = gridDim.x * gridDim.y * gridDim.z;
    unsigned sum, cnt, mine, sp = 0u;
    for (;;) {
        sum = 0u; cnt = 0u; mine = 0u;
#pragma unroll
        for (unsigned j = 0; j < 16; ++j) { const unsigned c = xb_ld(&bar[XB_XCNT(j)]); sum += c; cnt += (c > 0u) ? 1u : 0u; mine = (j == x) ? c : mine; }
        if (sum == G) break;
        __builtin_amdgcn_s_sleep(1);
        if ((++sp & 255u) == 0u) { if (xb_ld(&bar[XB_TMO])) break; if (sp > XB_SPIN_CAP) { atomicAdd(&bar[XB_TMO], 1u); break; } }
    }
    nloc = mine > 0u ? mine : 1u; nx = cnt > 0u ? cnt : 1u;
}

__device__ __forceinline__ void xcd_barrier(const XcdBarrier& b) {
    asm volatile("s_waitcnt vmcnt(0)" ::: "memory");
    __syncthreads();
    if (threadIdx.x == 0) {
        unsigned* bar = b.bar;
        __builtin_amdgcn_s_waitcnt(0);
        unsigned nloc = b.st[0], nx = b.st[1];
        if (nloc == 0u) { xcd_barrier_complete(bar, b.x, nloc, nx); b.st[0] = nloc; b.st[1] = nx; }
        const unsigned old = xb_add(&bar[XB_XSUB(b.x)], 1u);
        const unsigned gen = old / nloc;
        if (old + 1u == (gen + 1u) * nloc) {
            __builtin_amdgcn_fence(__ATOMIC_RELEASE, "agent");
            asm volatile("s_waitcnt vmcnt(0)" ::: "memory");
            const unsigned og = xb_add(&bar[XB_TOP], 1u);
            const unsigned tg = og / nx;
            if (og + 1u == (tg + 1u) * nx) xb_add(&bar[XB_TOPGEN], 1u);
            else XB_SPIN(xb_ld(&bar[XB_TOPGEN]) == tg, bar);
            __builtin_amdgcn_fence(__ATOMIC_ACQUIRE, "agent");
            xb_add(&bar[XB_XGEN(b.x)], 1u);
            asm volatile("s_waitcnt vmcnt(0)" ::: "memory");
        } else {
            XB_SPIN(xb_ld(&bar[XB_XGEN(b.x)]) == gen, bar);
            __builtin_amdgcn_fence(__ATOMIC_ACQUIRE, "agent");
            asm volatile("s_waitcnt vmcnt(0)" ::: "memory");
        }
    }
    __syncthreads();
}

struct Args { const float* in[42]; float* out; unsigned char* ws; int ph_lo, ph_hi; };
enum { PT_P0 = 0, PT_NORM, PT_FFN_IN, PT_RESID, PT_WIN0, PT_UP0, PT_ATT0, PT_WIN1, PT_ATT1 };
constexpr int NPH = 22;

__device__ __forceinline__ int srccol(int kind, int p) {
    const int tile = p >> 8, q = p & 255, bj = q >> 7, wc = (q & 127) >> 5, i = q & 31;
    switch (kind) {
        case 1: return bj * FF + tile * 128 + wc * 32 + 8 * ((i >> 2) & 3) + 4 * (i >> 4) + (i & 3);
        case 2: if (tile == 0) return q; if (tile == 1) return 288 + q; if (tile == 2) return bj == 0 ? 288 + 256 + q : (wc == 0 ? 256 + i : -1); return 672 + bj * 512 + (tile - 3) * 128 + (q & 127);
        case 3: return tile < 2 ? (4 * tile + wc) * 96 + 32 * bj + i : (2 * wc + bj) * 96 + 64 + i;
        case 4: return tile < 2 ? (4 * tile + wc) * 128 + 32 * bj + i : (4 * (tile - 2) + wc) * 128 + 64 + 32 * bj + i;
        case 5: return 64 * (4 * tile + wc) + 32 * bj + i;
        default: return p;
    }
}
__device__ __forceinline__ void cvt_item(const float* W, int K, int N, int Npad, int kind, const float* kg, bf16_t* WT, LAS float* scr, int item, int lane) {
    const int nblk = Npad / 32, kb = item / nblk, nb = item % nblk, k0 = 64 * kb, n0 = 32 * nb;
    const int src0 = srccol(kind, n0 + (lane & 31)) - (lane & 31);
    float vv[32];
#pragma unroll
    for (int i = 0; i < 32; ++i) { const int kk = 2 * i + (lane >> 5); vv[i] = (src0 + (lane & 31)) >= 0 ? ((const GAS float*)W)[(size_t)(k0 + kk) * N + src0 + (lane & 31)] : 0.f; }
    if (kg) {
#pragma unroll
        for (int i = 0; i < 32; ++i) vv[i] *= kg[k0 + 2 * i + (lane >> 5)]; }
#pragma unroll
    for (int i = 0; i < 32; ++i) scr[(2 * i + (lane >> 5)) * 33 + (lane & 31)] = vv[i];
    asm volatile("s_waitcnt lgkmcnt(0)" ::: "memory");
    const int c = lane & 7;
#pragma unroll
    for (int j = 0; j < 4; ++j) { const int n = (lane >> 3) + 8 * j; const LAS float* s = scr + (8 * c) * 33 + n;
        u32x4 o; o.x = pk2(s[0 * 33], s[1 * 33]); o.y = pk2(s[2 * 33], s[3 * 33]); o.z = pk2(s[4 * 33], s[5 * 33]); o.w = pk2(s[6 * 33], s[7 * 33]);
        *(GAS u32x4*)(WT + (size_t)(n0 + n) * K + k0 + 8 * c) = o; }
    asm volatile("s_waitcnt lgkmcnt(0)" ::: "memory");
}

__global__ void __launch_bounds__(512, 2) fwd(Args a) {
    extern __shared__ __attribute__((aligned(16))) unsigned char lds_raw[];
    LAS unsigned char* lds = (LAS unsigned char*)lds_raw;
    cg::grid_group grid = cg::this_grid();
    const int wave = __builtin_amdgcn_readfirstlane((int)threadIdx.x >> 6);
    { volatile LAS unsigned* st0 = (volatile LAS unsigned*)(lds + 133120); if (threadIdx.x < 2) st0[threadIdx.x] = 0u; }
    __syncthreads();
    const XcdBarrier xbar = xcd_barrier_post((unsigned*)(a.ws + WS_BAR), (volatile LAS unsigned*)(lds + 133120));
    for (int ph = a.ph_lo; ph < a.ph_hi; ++ph) {
    int G_l = gridDim.x, bx_l = blockIdx.x; asm volatile("" : "+s"(G_l), "+s"(bx_l));
    const int G = G_l, bx = bx_l;
    const int vcu = (G % 8 == 0) ? (bx % 8) * (G / 8) + bx / 8 : bx;
    const int gw = bx * 8 + wave, NGW = G * 8;
    unsigned char* ws = a.ws; asm volatile("" : "+s"(ws));
    typedef const float* cfp_t; typedef __attribute__((address_space(4))) const cfp_t* kin_t;
    __attribute__((address_space(4))) const unsigned char* kp_ = (__attribute__((address_space(4))) const unsigned char*)__builtin_amdgcn_kernarg_segment_ptr(); asm volatile("" : "+s"(kp_));
    const kin_t inp = (kin_t)kp_;
    float* ssq = (float*)(ws + WS_SSQ); float* mods = (float*)(ws + WS_MODS);
    float2* rope64 = (float2*)(ws + WS_ROPE64); float2* rope32 = (float2*)(ws + WS_ROPE32);
    bf16_t* Wb = (bf16_t*)(ws + WS_W); float* X = (float*)(ws + WS_X); bf16_t* H = (bf16_t*)(ws + WS_H); unsigned char* BIG = ws + WS_BIG;
    bf16_t* HID = (bf16_t*)BIG;
    {
        const int L = ph >= 12 ? 1 : 0;
        int pt, sub;
        switch (ph) {
            case 0: pt = PT_P0; sub = 0; break;
            case 1: case 12: pt = PT_NORM; sub = 0; break;
            case 4: case 15: pt = PT_NORM; sub = 1; break;
            case 9: case 19: pt = PT_NORM; sub = 2; break;
            case 2: case 13: pt = PT_FFN_IN; sub = 0; break;
            case 10: case 20: pt = PT_FFN_IN; sub = 2; break;
            case 3: case 14: pt = PT_RESID; sub = 0; break;
            case 8: case 18: pt = PT_RESID; sub = 1; break;
            case 11: case 21: pt = PT_RESID; sub = 2; break;
            case 5: pt = PT_WIN0; sub = 0; break;
            case 6: pt = PT_UP0; sub = 0; break;
            case 7: pt = PT_ATT0; sub = 0; break;
            case 16: pt = PT_WIN1; sub = 0; break;
            default: pt = PT_ATT1; sub = 0; break;
        }
        const bool first = (ph <= 3);
        const bool tail = (L == 1 && ph >= 18);
        const int Mrows = tail ? TL : TA;
        const float* modL = mods + (size_t)L * 9 * NMODC;
        const int ib = L ? 26 : 4;

        if (pt == PT_P0) {
            const int lane = lane_opaque(), tid = wave * 64 + lane;
            LAS float* sil = (LAS float*)lds; LAS float* red = (LAS float*)(lds + 36864);
            for (int i = tid; i < 9 * 1024; i += 512) { const int mi = i >> 10, k = i & 1023; const float c = mi < 8 ? inp[1][mi * 1024 + k] : inp[3][k]; sil[i] = c * __builtin_amdgcn_rcpf(1.f + __expf(-c)); }
            __syncthreads();
            for (int it = bx; it < 288; it += G) {
                const int l = it / 144, cgp = it % 144, col = cgp * 64 + lane, k0 = wave * 128;
                const float* mw = inp[l ? 26 : 4] + (size_t)k0 * NMODC + col;
                float ac[9];
#pragma unroll
                for (int mi = 0; mi < 9; ++mi) ac[mi] = 0.f;
#pragma unroll 4
                for (int k = 0; k < 128; ++k) { const float w = ((const GAS float*)mw)[(size_t)k * NMODC];
#pragma unroll
                    for (int mi = 0; mi < 9; ++mi) ac[mi] += sil[mi * 1024 + k0 + k] * w; }
#pragma unroll
                for (int mi = 0; mi < 9; ++mi) red[(wave * 9 + mi) * 64 + lane] = ac[mi];
                __syncthreads();
                for (int idx = tid; idx < 576; idx += 512) { const int mi = idx >> 6, ln = idx & 63; float s = inp[l ? 27 : 5][cgp * 64 + ln];
#pragma unroll
                    for (int w = 0; w < 8; ++w) s += red[(w * 9 + mi) * 64 + ln];
                    mods[((size_t)l * 9 + mi) * NMODC + cgp * 64 + ln] = s; }
                __syncthreads();
            }
            __syncthreads();
            LAS float* scr = (LAS float*)(lds + wave * 8448);
            for (int j = 0; j < 14; ++j) {
                int idx, K, N, Npad, kind, kgi = -1; size_t off;
                switch (j) {
                    case 0: idx = 7; K = 1024; N = 5632; Npad = 5632; kind = 1; off = W_F1I0; break;
                    case 1: idx = 8; K = 2816; N = 1024; Npad = 1024; kind = 0; off = W_F1O0; break;
                    case 2: idx = 10; K = 1024; N = 1696; Npad = 1792; kind = 2; off = W_WIN0; break;
                    case 3: idx = 12; K = 384; N = 768; Npad = 768; kind = 3; kgi = 11; off = W_UQ; break;
                    case 4: idx = 14; K = 256; N = 1024; Npad = 1024; kind = 4; kgi = 13; off = W_UKV; break;
                    case 5: idx = 22; K = 1024; N = 1024; Npad = 1024; kind = 0; off = W_WO0; break;
                    case 6: idx = 24; K = 1024; N = 5632; Npad = 5632; kind = 1; off = W_F2I0; break;
                    case 7: idx = 25; K = 2816; N = 1024; Npad = 1024; kind = 0; off = W_F2O0; break;
                    case 8: idx = 29; K = 1024; N = 5632; Npad = 5632; kind = 1; off = W_F1I1; break;
                    case 9: idx = 30; K = 2816; N = 1024; Npad = 1024; kind = 0; off = W_F1O1; break;
                    case 10: idx = 32; K = 1024; N = 2304; Npad = 2304; kind = 5; off = W_WIN1; break;
                    case 11: idx = 38; K = 1024; N = 1024; Npad = 1024; kind = 0; off = W_WO1; break;
                    case 12: idx = 40; K = 1024; N = 5632; Npad = 5632; kind = 1; off = W_F2I1; break;
                    default: idx = 41; K = 2816; N = 1024; Npad = 1024; kind = 0; off = W_F2O1; break;
                }
                const int nitems = (K / 64) * (Npad / 32);
                const float* kg = kgi >= 0 ? inp[kgi] : nullptr;
                for (int it = gw; it < nitems; it += NGW) cvt_item(inp[idx], K, N, Npad, kind, kg, Wb + off, scr, it, lane);
            }
            const int gt = bx * 512 + tid, NT = G * 512;
            for (int i = gt; i < 4096 * 32; i += NT) { const int t = i >> 5, p = i & 31; const float pos = p < 16 ? (float)(t >> 6) : (float)(t & 63);
                const float inv = powf(10000.f, -(float)(p & 15) / 16.f); float s, c; sincosf(pos * inv, &s, &c); rope64[i] = make_float2(c, s); }
            for (int i = gt; i < 4096 * 16; i += NT) { const int t = i >> 4, p = i & 15; const float pos = p < 8 ? (float)(t >> 6) : (float)(t & 63);
                const float inv = powf(10000.f, -(float)(p & 7) / 8.f); float s, c; sincosf(pos * inv, &s, &c); rope32[i] = make_float2(c, s); }
            for (int i = gt; i < 2 * TA; i += NT) ssq[i] = 0.f;
        } else if (pt == PT_NORM) {
            const int lane = lane_opaque();
            const float* xl = first ? inp[0] : X; const float* xc = first ? inp[2] : X + (size_t)TL * DM;
            const float* gain = inp[ib + (sub == 0 ? 2 : sub == 1 ? 5 : (L ? 13 : 19))];
            const int shi = sub * 3, sci = sub * 3 + 1;
            for (int row = gw; row < Mrows; row += NGW) {
                const float* xr = row < TL ? xl + (size_t)row * DM : xc + (size_t)(row - TL) * DM; const int mi = row < TL ? (row >> 12) : 8;
                f32x4 v[4]; float ss = 0.f;
#pragma unroll
                for (int j = 0; j < 4; ++j) { v[j] = *(const GAS f32x4*)(xr + lane * 4 + 256 * j); ss += dot4(v[j]); }
                if (ph > 1 && row >= TL) {
                    const float* pp = (const float*)(BIG + 188 * MiB) + (size_t)(row - TL) * DM + lane * 4; ss = 0.f;
#pragma unroll
                    for (int j = 0; j < 4; ++j) {
                        f32x4 xv = ph == 4 ? *(const GAS f32x4*)(inp[2] + (size_t)(row - TL) * DM + lane * 4 + 256 * j) : v[j];
#pragma unroll
                        for (int s4 = 0; s4 < 4; ++s4) xv = xv + *(const GAS f32x4*)(pp + (size_t)s4 * TC * DM + 256 * j);
                        v[j] = xv; ss += dot4(xv); *(GAS f32x4*)(X + (size_t)row * DM + lane * 4 + 256 * j) = xv; }
                }
                const float rstd = __builtin_amdgcn_rsqf(wave_sum(ss) * (1.f / DM) + EPS);
                const float* mp = modL + (size_t)mi * NMODC;
#pragma unroll
                for (int j = 0; j < 4; ++j) { const int col = lane * 4 + 256 * j;
                    const f32x4 g = *(const GAS f32x4*)(gain + col), sc = *(const GAS f32x4*)(mp + sci * 1024 + col), sh = *(const GAS f32x4*)(mp + shi * 1024 + col);
                    st_bf4(H + (size_t)row * DM + col, v[j] * rstd * g * (sc + 1.f) + sh); }
            }
        } else if (pt == PT_FFN_IN) {
            const size_t off = L ? (sub == 0 ? W_F1I1 : W_F2I1) : (sub == 0 ? W_F1I0 : W_F2I0);
            pg8::Gemm g{H, Wb + off, Mrows, 5632, 1024, 1024}; pg8::StaticOrder S; S.init(Mrows, 5632, 1024, G, bx);
            EpiSwiglu E{HID};
            pg8::gemm_phase<EpiSwiglu>(lds, g, S, E, wave);
        } else if (pt == PT_RESID) {
            const bool mix = (sub == 1);
            const size_t off = L ? (sub == 0 ? W_F1O1 : sub == 1 ? W_WO1 : W_F2O1) : (sub == 0 ? W_F1O0 : sub == 1 ? W_WO0 : W_F2O0);
            const int K = mix ? 1024 : FF;
            pg8::Gemm g{mix ? H : HID, Wb + off, Mrows, 1024, K, K}; pg8::StaticOrder S; S.init(TL, 1024, K, G, bx, tail ? 0 : TC);
            const bool lastp = (ph == NPH - 1);
            EpiResid E{first ? inp[0] : X, first ? inp[2] : X + (size_t)TL * DM, lastp ? a.out : X, modL + (sub == 0 ? 2 : sub == 1 ? 5 : 8) * 1024, (float*)(BIG + 188 * MiB), mix ? 1.f : 0.5f};
            pg8::gemm_phase<EpiResid>(lds, g, S, E, wave);
        } else if (pt == PT_WIN0) {
            pg8::Gemm g{H, Wb + W_WIN0, TA, 1792, 1024, 1024}; pg8::StaticOrder S; S.init(TA, 1792, 1024, G, bx);
            EpiWin0 E{(bf16_t*)(BIG + B0_CKV), (bf16_t*)(BIG + B0_CQ), (bf16_t*)(BIG + B0_Y), (bf16_t*)(BIG + B0_K), ssq, ssq + TA, inp[17], inp[16], rope32};
            pg8::gemm_phase<EpiWin0>(lds, g, S, E, wave);
        } else if (pt == PT_UP0) {
            { pg8::Gemm g{(bf16_t*)(BIG + B0_CQ), Wb + W_UQ, TA, 768, 384, 384}; pg8::StaticOrder S; S.init(TA, 768, 384, G, bx);
              EpiQup E{ssq + TA, inp[15], rope32, (bf16_t*)(BIG + B0_Q), 0.10206207261596575f * LOG2E};
              pg8::gemm_phase<EpiQup>(lds, g, S, E, wave); }
            { pg8::Gemm g{(bf16_t*)(BIG + B0_CKV), Wb + W_UKV, TA, 1024, 256, 256}; pg8::StaticOrder S; S.init(TA, 1024, 256, G, bx);
              EpiKvup E{ssq, inp[16], (bf16_t*)(BIG + B0_K), (bf16_t*)(BIG + B0_V)};
              pg8::gemm_phase<EpiKvup>(lds, g, S, E, wave); }
            {
                const bf16_t* Y = (const bf16_t*)(BIG + B0_Y);
                const float *dw_w = inp[18], *dw_b = inp[19], *ln_g = inp[20], *ln_b = inp[21];
                LAS float* red = (LAS float*)lds;
                const int lane = lane_opaque(), tid = wave * 64 + lane;
                const int tg = tid >> 8, cp = tid & 255, w4 = (tid >> 6) & 3;
                for (int un = bx; un < TA / 16; un += G) {
                    const int row0 = un * 16 + tg * 8;
                    int lo, hi_;
                    if (row0 < TL) { lo = row0 & ~4095; hi_ = lo + 4096; } else { lo = TL + ((row0 - TL) & ~255); hi_ = lo + 256; }
                    unsigned yw[38];
#pragma unroll
                    for (int i = 0; i < 38; ++i) { const int r = row0 - 15 + i; yw[i] = (r >= lo && r < hi_) ? *(const GAS unsigned*)(Y + (size_t)r * 512 + 2 * cp) : 0u; }
                    float a0[8], a1[8];
                    const float2 bb = *(const float2*)(dw_b + 2 * cp);
#pragma unroll
                    for (int t = 0; t < 8; ++t) { a0[t] = bb.x; a1[t] = bb.y; }
#pragma unroll
                    for (int k = 0; k < 31; ++k) { const float2 w = *(const float2*)(dw_w + k * 512 + 2 * cp);
#pragma unroll
                        for (int t = 0; t < 8; ++t) { a0[t] += bflo(yw[t + k]) * w.x; a1[t] += bfhi(yw[t + k]) * w.y; }
                        if ((k & 3) == 3) asm volatile("" ::: "memory"); }
#pragma unroll
                    for (int t = 0; t < 8; ++t) { const float s = wave_sum(a0[t] + a1[t]), q = wave_sum(a0[t] * a0[t] + a1[t] * a1[t]);
                        if (lane == 0) { red[((tg * 4 + w4) * 8 + t) * 2] = s; red[((tg * 4 + w4) * 8 + t) * 2 + 1] = q; } }
                    __syncthreads();
                    const float2 gg = *(const float2*)(ln_g + 2 * cp), lb = *(const float2*)(ln_b + 2 * cp);
#pragma unroll
                    for (int t = 0; t < 8; ++t) { float s = 0.f, q = 0.f;
#pragma unroll
                        for (int w = 0; w < 4; ++w) { s += red[((tg * 4 + w) * 8 + t) * 2]; q += red[((tg * 4 + w) * 8 + t) * 2 + 1]; }
                        const float mu = s * (1.f / 512.f), var = fmaxf(q * (1.f / 512.f) - mu * mu, 0.f), rstd = __builtin_amdgcn_rsqf(var + EPS);
                        const float y0 = (a0[t] - mu) * rstd * gg.x + lb.x, y1 = (a1[t] - mu) * rstd * gg.y + lb.y;
                        *(unsigned*)(H + (size_t)(row0 + t) * DM + 512 + 2 * cp) = pk2(y0 * sigmoidf_(y0), y1 * sigmoidf_(y1)); }
                    __syncthreads();
                }
            }
        } else if (pt == PT_ATT0) {
            const bf16_t* Q0 = (const bf16_t*)(BIG + B0_Q); const bf16_t* K0 = (const bf16_t*)(BIG + B0_K); const bf16_t* V0 = (const bf16_t*)(BIG + B0_V);
            for (int un = vcu; un < 1024 + 64; un += G) {
                if (un < 1024) { const int bh = un >> 4, qb = un & 15, b = bh >> 3, h = bh & 7; const size_t qrow = (size_t)b * 4096 + qb * 256;
                    attn_unit<96, false>(lds, Q0 + qrow * 768 + h * 96, 768, K0 + (size_t)b * KVB * 768 + h * 96, 768, V0 + (size_t)b * KVB * 512 + h * 64, 512, H + qrow * DM + h * 64, DM, 68, 0, 0, nullptr, wave);
                } else { const int idx = un - 1024, b = idx >> 3, h = idx & 7; const size_t qrow = (size_t)TL + b * 256;
                    attn_unit<96, false>(lds, Q0 + qrow * 768 + h * 96, 768, K0 + (size_t)b * KVB * 768 + h * 96, 768, V0 + (size_t)b * KVB * 512 + h * 64, 512, H + qrow * DM + h * 64, DM, 4, 0, 0, nullptr, wave); }
            }
        } else if (pt == PT_WIN1) {
            pg8::Gemm g{H, Wb + W_WIN1, TA, 2304, 1024, 1024}; pg8::StaticOrder S; S.init(TA, 2304, 1024, G, bx);
            EpiWin1 E{(bf16_t*)(BIG + B1_QG), (bf16_t*)(BIG + B1_QN), (bf16_t*)(BIG + B1_KG), (bf16_t*)(BIG + B1_VG), (bf16_t*)(BIG + B1_KN), (bf16_t*)(BIG + B1_VN),
                      inp[33], inp[34], inp[35], inp[36], rope64, 0.125f * LOG2E};
            pg8::gemm_phase<EpiWin1>(lds, g, S, E, wave);
        } else if (pt == PT_ATT1) {
            const bf16_t* Qg = (const bf16_t*)(BIG + B1_QG); const bf16_t* Qn = (const bf16_t*)(BIG + B1_QN); const bf16_t* Kg = (const bf16_t*)(BIG + B1_KG);
            const bf16_t* Vg = (const bf16_t*)(BIG + B1_VG); const bf16_t* Kn = (const bf16_t*)(BIG + B1_KN); const bf16_t* Vn = (const bf16_t*)(BIG + B1_VN);
            for (int un = vcu; un < 2048; un += G) {
                const int u2 = un & 1023, bh = u2 >> 4, qb = u2 & 15, b = bh >> 3, h = bh & 7; const size_t qrow = (size_t)b * 4096 + qb * 256;
                if (un < 1024) {
                    attn_unit<64, false>(lds, Qg + qrow * 512 + h * 64, 512, Kg + (size_t)b * KVB * 128 + (h >> 2) * 64, 128, Vg + (size_t)b * KVB * 128 + (h >> 2) * 64, 128, H + qrow * DM + h * 64, DM, 68, 0, 0, nullptr, wave);
                } else {
                    const int g4 = qb * 4, rho0 = min(max(g4 - 4, 0), 56), rho1 = min(max(g4 + 3 - 4, 0), 56) + 7;
                    attn_unit<64, true>(lds, Qn + qrow * 512 + h * 64, 512, Kn + (size_t)b * KVB * 512 + h * 64, 512, Vn + (size_t)b * KVB * 512 + h * 64, 512, H + qrow * DM + 512 + h * 64, DM,
                                        4 + (rho1 - rho0 + 1), rho0, g4, inp[37] + h * 15 * 31, wave);
                }
            }
        }
        if (ph + 1 < a.ph_hi) { if (ph == 0) grid.sync(); else xcd_barrier(xbar); }
    }
    }
}

extern "C" void kernel_launch(void* const* d_in, const int* in_sizes, int n_in, void* d_out, int out_size, void* d_ws, size_t ws_size, hipStream_t stream) {
    static int grid = 0;
    if (grid == 0) {
        int dev = 0, cus = 0;
        if (hipGetDevice(&dev) != hipSuccess || hipDeviceGetAttribute(&cus, hipDeviceAttributeMultiprocessorCount, dev) != hipSuccess) { fprintf(stderr, "kernel_launch: device query failed\n"); grid = -1; return; }
        if (hipFuncSetAttribute((const void*)fwd, hipFuncAttributeMaxDynamicSharedMemorySize, LDS_BYTES) != hipSuccess) { fprintf(stderr, "kernel_launch: hipFuncSetAttribute failed\n"); grid = -1; return; }
        int per_cu = 0;
        if (hipOccupancyMaxActiveBlocksPerMultiprocessor(&per_cu, (const void*)fwd, 512, LDS_BYTES) != hipSuccess || per_cu < 1) fprintf(stderr, "kernel_launch: occupancy query says %d\n", per_cu);
        (void)hipGetLastError();
        grid = cus;
        if (n_in != 42 || ws_size < 512 * MiB) fprintf(stderr, "kernel_launch: unexpected n_in %d / ws %zu\n", n_in, ws_size);
    }
    if (grid < 0) return;
    Args a{};
    for (int i = 0; i < 42; ++i) a.in[i] = (const float*)d_in[i];
    a.out = (float*)d_out; a.ws = (unsigned char*)d_ws;
    if (hipMemsetAsync((char*)d_ws + WS_BAR, 0, XCD_BAR_WORDS * 4, stream) != hipSuccess) { fprintf(stderr, "kernel_launch: memset failed\n"); return; }
#if ONE_LAUNCH
    a.ph_lo = 0; a.ph_hi = NPH;
    void* args[] = {&a};
    hipError_t e = hipLaunchCooperativeKernel((const void*)fwd, dim3(grid), dim3(512), args, LDS_BYTES, stream);
    if (e != hipSuccess) fprintf(stderr, "kernel_launch: cooperative launch failed: %s\n", hipGetErrorString(e));
#else
    for (int ph = 0; ph < NPH; ++ph) { a.ph_lo = ph; a.ph_hi = ph + 1; hipLaunchKernelGGL(fwd, dim3(grid), dim3(512), LDS_BYTES, stream, a); }
#endif
}
```

```cpp
#include <hip/hip_runtime.h>
#include <hip/hip_cooperative_groups.h>
#include <cstdio>
#include <cstdint>
namespace cg = cooperative_groups;

#ifndef ONE_LAUNCH
#define ONE_LAUNCH 1
#endif

#define LAS __attribute__((address_space(3)))
#define GAS __attribute__((address_space(1)))
typedef unsigned short bf16_t;
typedef short bf16x8 __attribute__((ext_vector_type(8)));
typedef float f32x4 __attribute__((ext_vector_type(4)));
typedef float f32x16 __attribute__((ext_vector_type(16)));
typedef unsigned u32x2 __attribute__((ext_vector_type(2)));
typedef unsigned u32x4 __attribute__((ext_vector_type(4)));
typedef float f32x2_t __attribute__((ext_vector_type(2)));
typedef __bf16 bf16x2_t __attribute__((ext_vector_type(2)));

__device__ __forceinline__ unsigned pk2(float lo, float hi) { f32x2_t v = {lo, hi}; bf16x2_t b = __builtin_convertvector(v, bf16x2_t); return __builtin_bit_cast(unsigned, b); }
__device__ __forceinline__ float bflo(unsigned w) { return __uint_as_float(w << 16); }
__device__ __forceinline__ float bfhi(unsigned w) { return __uint_as_float(w & 0xffff0000u); }
__device__ __forceinline__ float wave_sum(float v) {
#pragma unroll
    for (int o = 1; o < 64; o <<= 1) v += __shfl_xor(v, o);
    return v;
}

__device__ __forceinline__ int lane_opaque() { unsigned m1 = ~0u; asm volatile("" : "+s"(m1)); int l = (int)__builtin_amdgcn_mbcnt_hi(m1, __builtin_amdgcn_mbcnt_lo(m1, 0u)); asm volatile("" : "+v"(l)); return l; }
constexpr int TL = 32768, TC = 2048, TA = TL + TC, DM = 1024, FF = 2816, NMODC = 9216;
constexpr int KVB = 4352;
constexpr float EPS = 1e-6f;
constexpr float LOG2E = 1.4426950408889634f;
__device__ __forceinline__ int kvrow_of(int row) { return row < TL ? (row >> 12) * KVB + 256 + (row & 4095) : ((row - TL) >> 8) * KVB + ((row - TL) & 255); }

constexpr size_t MiB = 1u << 20;
constexpr size_t WS_SSQ = 0;
constexpr size_t WS_BAR = 384 * 1024;
constexpr size_t WS_MODS = 512 * 1024;
constexpr size_t WS_ROPE64 = 2 * MiB;
constexpr size_t WS_ROPE32 = 3 * MiB;
constexpr size_t WS_W = 4 * MiB;
constexpr size_t WS_X = 84 * MiB;
constexpr size_t WS_H = 220 * MiB;
constexpr size_t WS_BIG = 288 * MiB;
constexpr size_t E_FIN = (size_t)5632 * 1024, E_FOUT = (size_t)1024 * 2816;
constexpr size_t W_F1I0 = 0, W_F1O0 = W_F1I0 + E_FIN, W_WIN0 = W_F1O0 + E_FOUT, W_UQ = W_WIN0 + (size_t)1792 * 1024, W_UKV = W_UQ + (size_t)768 * 384,
                 W_WO0 = W_UKV + (size_t)1024 * 256, W_F2I0 = W_WO0 + (size_t)1024 * 1024, W_F2O0 = W_F2I0 + E_FIN,
                 W_F1I1 = W_F2O0 + E_FOUT, W_F1O1 = W_F1I1 + E_FIN, W_WIN1 = W_F1O1 + E_FOUT, W_WO1 = W_WIN1 + (size_t)2304 * 1024,
                 W_F2I1 = W_WO1 + (size_t)1024 * 1024, W_F2O1 = W_F2I1 + E_FIN, W_END = W_F2O1 + E_FOUT;
static_assert(W_END * 2 <= 80 * MiB, "weights fit");
constexpr size_t B0_CKV = 0, B0_CQ = 17 * MiB, B0_Y = B0_CQ + 26 * MiB, B0_Q = B0_Y + 34 * MiB, B0_K = B0_Q + 51 * MiB, B0_V = B0_K + 51 * MiB;
constexpr size_t B1_QG = 0, B1_QN = 34 * MiB, B1_KG = 68 * MiB, B1_VG = 77 * MiB, B1_KN = 86 * MiB, B1_VN = 120 * MiB;
constexpr int LDS_BYTES = 135168;

namespace pg8 {
constexpr int BM = 256, BK = 64, HALF = 128, HTB = HALF * BK * 2, STAGE_BYTES = 8 * HTB, NXCD = 8, WGM = 8;
__host__ __device__ __forceinline__ int lds_byte(int r, int c) { const int st = (r >> 4) * 2 + (c >> 5), rr = r & 15, cc = c & 31, ob = rr * 64 + cc * 2; return st * 1024 + (ob ^ (((ob >> 9) & 1) << 5)); }
__host__ __device__ __forceinline__ void stage_rc(int b, int& R, int& C) { const int st = b / 1024, sb = b % 1024, swz = sb ^ (((sb >> 9) & 1) << 5); R = (st >> 1) * 16 + swz / 64; C = (st & 1) * 32 + (swz % 64) / 2; }
struct Unit { int pm, pn, k0, nt, split; };
struct Gemm { const bf16_t* A; const bf16_t* Bt; int M, N, K, lda; };
struct StaticOrder {
    int nM, nN, nwg, G, c, ntK, nsub;
    __device__ void init(int M, int N, int K, int G_, int c_, int sub_rows = 0) { nM = M / BM; nN = N / BM; nwg = nM * nN; G = G_; c = c_; ntK = K / BK; nsub = (sub_rows / BM) * nN * 4; }
    __device__ __forceinline__ bool next(int i, Unit& u) const {
        const long L = (long)i * G + c; const bool ok = L < nwg + nsub;
        int pm = 0, pn = 0, k0 = 0, nt = ntK, split = 0;
        if (L >= nwg) {
            const int j = (int)L - nwg, ks = j & 3, tile = j >> 2;
            pn = tile % nN; pm = nM + tile / nN; split = 1 + ks;
            const int nt44 = ks < 2 ? 12 : 10, k44 = ks < 2 ? 12 * ks : 24 + 10 * (ks - 2), ntg = ntK >> 2;
            nt = ntK == 44 ? nt44 : ntg; k0 = ntK == 44 ? k44 : ks * ntg;
        } else {
            int wgid = (int)L; { const int q = nwg / NXCD, r = nwg % NXCD, xcd = wgid % NXCD, off = wgid / NXCD; wgid = (xcd < r ? xcd * (q + 1) : r * (q + 1) + (xcd - r) * q) + off; }
            const int nig = WGM * nN, gid = wgid / nig, fm = gid * WGM, gsz = (nM - fm) < WGM ? (nM - fm) : WGM;
            pm = fm + ((wgid % nig) % gsz); pn = (wgid % nig) / gsz;
        }
        u.pm = pm; u.pn = pn; u.k0 = k0; u.nt = nt; u.split = split;
        return ok;
    }
};
template <class Epi>
__device__ __forceinline__ void gemm_phase(LAS unsigned char* lds, const Gemm g, const StaticOrder& S, const Epi& E, int wave_s) {
    const int lane = lane_opaque(), wid = wave_s, tid = wid * 64 + lane, wr = wid >> 2, wc = wid & 3, fr = lane & 15, fq = lane >> 4;
    const int K = g.K, lda = g.lda;
    unsigned voffA[2], voffB[2];
#pragma unroll
    for (int i = 0; i < 2; ++i) { int R, C; stage_rc(tid * 16 + i * 8192, R, C); voffA[i] = (unsigned)(R * lda + C) * 2u; voffB[i] = (unsigned)(R * K + C) * 2u; }
    const size_t kstep = (size_t)(BK * 2);
    const size_t hstepA = (size_t)HALF * lda * 2, hstepB = (size_t)HALF * K * 2;
    const size_t tstepA = 2 * hstepA, tstepB = 2 * hstepB;
    const unsigned ldsw = (unsigned)wid * 1024u;
    const int aoff = lds_byte(wr * 64 + fr, fq * 8), boff = lds_byte(wc * 32 + fr, fq * 8);
#define PG8_SA(b, h) (((b) * 2 + (h)) * HTB)
#define PG8_SB(b, h) ((4 + (b) * 2 + (h)) * HTB)
#define PG8_STAGE(bufoff, gbase, voff) do { _Pragma("unroll") for (int _i = 0; _i < 2; ++_i) \
        __builtin_amdgcn_global_load_lds((const unsigned*)((const char*)(gbase) + (voff)[_i]), (LAS unsigned*)(lds + (bufoff) + ldsw + _i * 8192), 16, 0, 0); } while (0)
#define PG8_LDA(dst, b, h) do { _Pragma("unroll") for (int m = 0; m < 4; ++m) _Pragma("unroll") for (int k = 0; k < 2; ++k) dst[m][k] = *(const LAS bf16x8*)(lds + PG8_SA(b, h) + aoff + m * 2048 + k * 1024); } while (0)
#define PG8_LDB(dst, b, h) do { _Pragma("unroll") for (int n = 0; n < 2; ++n) _Pragma("unroll") for (int k = 0; k < 2; ++k) dst[n][k] = *(const LAS bf16x8*)(lds + PG8_SB(b, h) + boff + n * 2048 + k * 1024); } while (0)
#define PG8_MMA(ai, bj, At, Bt) do { __builtin_amdgcn_s_setprio(1); _Pragma("unroll") for (int m = 0; m < 4; ++m) _Pragma("unroll") for (int n = 0; n < 2; ++n) _Pragma("unroll") for (int k = 0; k < 2; ++k) \
        acc[ai][bj][m][n] = __builtin_amdgcn_mfma_f32_16x16x32_bf16(Bt[n][k], At[m][k], acc[ai][bj][m][n], 0, 0, 0); __builtin_amdgcn_s_setprio(0); } while (0)
#define PG8_WAIT_V(n) asm volatile("s_waitcnt vmcnt(" #n ")" ::: "memory")
#define PG8_WAIT_L(n) asm volatile("s_waitcnt lgkmcnt(" #n ")" ::: "memory")
#define PG8_BAR __builtin_amdgcn_s_barrier()
#define PG8_SCHED __builtin_amdgcn_sched_barrier(0)
    Unit cur, nxt; int ui = 0;
    if (!S.next(0, cur)) return;
    f32x4 acc[2][2][4][2];
#pragma unroll
    for (int a = 0; a < 2; ++a)
#pragma unroll
        for (int b = 0; b < 2; ++b)
#pragma unroll
            for (int m = 0; m < 4; ++m)
#pragma unroll
                for (int n = 0; n < 2; ++n) acc[a][b][m][n] = (f32x4){0.f, 0.f, 0.f, 0.f};
    bf16x8 At[4][2], B0[2][2], B1[2][2];
    const char* cA = (const char*)g.A + (size_t)cur.pm * tstepA + (size_t)cur.k0 * kstep; const char* cB = (const char*)g.Bt + (size_t)cur.pn * tstepB + (size_t)cur.k0 * kstep;
    PG8_STAGE(PG8_SB(0, 0), cB, voffB); PG8_STAGE(PG8_SB(0, 1), cB + hstepB, voffB); PG8_STAGE(PG8_SA(0, 0), cA, voffA); PG8_STAGE(PG8_SA(0, 1), cA + hstepA, voffA);
    if (wr == 1) PG8_BAR;
    PG8_WAIT_V(2); PG8_BAR;
    PG8_STAGE(PG8_SB(1, 0), cB + kstep, voffB); PG8_STAGE(PG8_SA(1, 0), cA + kstep, voffA); PG8_STAGE(PG8_SB(1, 1), cB + hstepB + kstep, voffB);
    PG8_WAIT_V(6); PG8_BAR;
    for (;;) {
        const bool has_next = S.next(ui + 1, nxt);
        const char* nA = has_next ? (const char*)g.A + (size_t)nxt.pm * tstepA + (size_t)nxt.k0 * kstep : cA; const char* nB = has_next ? (const char*)g.Bt + (size_t)nxt.pn * tstepB + (size_t)nxt.k0 * kstep : cB;
        const int nt = cur.nt;
        for (int t = 0; t < nt; t += 2) {
            const bool last = (t == nt - 2);
            const char* a1 = cA + (size_t)(t + 1) * kstep;
            const char* a2 = last ? nA : cA + (size_t)(t + 2) * kstep; const char* b2 = last ? nB : cB + (size_t)(t + 2) * kstep;
            const char* a3 = a2 + kstep; const char* b3 = b2 + kstep;
            PG8_LDB(B0, 0, 0); PG8_LDB(B1, 0, 1); PG8_SCHED; PG8_LDA(At, 0, 0); PG8_STAGE(PG8_SA(1, 1), a1 + hstepA, voffA);
            PG8_WAIT_V(8); PG8_WAIT_L(0); PG8_BAR; PG8_MMA(0, 0, At, B0); PG8_MMA(0, 1, At, B1); PG8_BAR; PG8_SCHED;
            PG8_LDA(At, 0, 1); PG8_STAGE(PG8_SB(0, 0), b2, voffB); PG8_STAGE(PG8_SB(0, 1), b2 + hstepB, voffB); PG8_STAGE(PG8_SA(0, 0), a2, voffA);
            PG8_WAIT_V(8); PG8_WAIT_L(0); PG8_BAR; PG8_MMA(1, 0, At, B0); PG8_MMA(1, 1, At, B1); PG8_BAR; PG8_SCHED;
            PG8_LDB(B0, 1, 0); PG8_LDB(B1, 1, 1); PG8_SCHED; PG8_LDA(At, 1, 0); PG8_STAGE(PG8_SA(0, 1), a2 + hstepA, voffA);
            PG8_WAIT_V(8); PG8_WAIT_L(0); PG8_BAR; PG8_MMA(0, 0, At, B0); PG8_MMA(0, 1, At, B1); PG8_BAR; PG8_SCHED;
            PG8_LDA(At, 1, 1); PG8_STAGE(PG8_SB(1, 0), b3, voffB); PG8_STAGE(PG8_SB(1, 1), b3 + hstepB, voffB); PG8_STAGE(PG8_SA(1, 0), a3, voffA);
            PG8_WAIT_V(8); PG8_WAIT_L(0); PG8_BAR; PG8_MMA(1, 0, At, B0); PG8_MMA(1, 1, At, B1); PG8_BAR; PG8_SCHED;
        }
        if (wr == 0) PG8_BAR;
        { const int l2 = lane_opaque(); E(acc, cur, wr, wc, l2 & 15, l2 >> 4); }
        if (!has_next) break;
#pragma unroll
        for (int a = 0; a < 2; ++a)
#pragma unroll
            for (int b = 0; b < 2; ++b)
#pragma unroll
                for (int m = 0; m < 4; ++m)
#pragma unroll
                    for (int n = 0; n < 2; ++n) acc[a][b][m][n] = (f32x4){0.f, 0.f, 0.f, 0.f};
        cur = nxt; cA = nA; cB = nB; ++ui;
        if (wr == 1) PG8_BAR;
    }
    PG8_WAIT_V(0);
    PG8_BAR;
#undef PG8_SA
#undef PG8_SB
#undef PG8_STAGE
#undef PG8_LDA
#undef PG8_LDB
#undef PG8_MMA
#undef PG8_WAIT_V
#undef PG8_WAIT_L
#undef PG8_BAR
#undef PG8_SCHED
}
}
using pg8::Unit;
typedef f32x4 AccT[2][2][4][2];

__device__ __forceinline__ void st_bf4(bf16_t* p, f32x4 v) { u32x2 w; w.x = pk2(v[0], v[1]); w.y = pk2(v[2], v[3]); *(GAS u32x2*)p = w; }
__device__ __forceinline__ float dot4(f32x4 v) { return (v[0] * v[0] + v[1] * v[1]) + (v[2] * v[2] + v[3] * v[3]); }
__device__ __forceinline__ float fq_sum(float s) { s += __shfl_xor(s, 16); s += __shfl_xor(s, 32); return s; }
__device__ __forceinline__ f32x4 rope4(f32x4 v, const float2* tab) {
    const float2 a = tab[0], b = tab[1];
    return (f32x4){v[0] * a.x - v[1] * a.y, v[0] * a.y + v[1] * a.x, v[2] * b.x - v[3] * b.y, v[2] * b.y + v[3] * b.x};
}
__device__ __forceinline__ float sigmoidf_(float x) { return __builtin_amdgcn_rcpf(1.f + __expf(-x)); }

struct EpiSwiglu {
    bf16_t* hid;
    __device__ __forceinline__ void operator()(const AccT& acc, const Unit& u, int wr, int wc, int fr, int fq) const {
#pragma unroll
        for (int ai = 0; ai < 2; ++ai)
#pragma unroll
            for (int m = 0; m < 4; ++m) {
                const int row = u.pm * 256 + ai * 128 + wr * 64 + m * 16 + fr;
                bf16_t* rp = hid + (size_t)row * FF + u.pn * 128 + wc * 32 + fq * 8;
                u32x4 w;
#pragma unroll
                for (int n = 0; n < 2; ++n) { const f32x4 g = acc[ai][0][m][n], uu = acc[ai][1][m][n]; f32x4 h;
#pragma unroll
                    for (int j = 0; j < 4; ++j) h[j] = g[j] * sigmoidf_(g[j]) * uu[j];
                    if (n == 0) { w.x = pk2(h[0], h[1]); w.y = pk2(h[2], h[3]); } else { w.z = pk2(h[0], h[1]); w.w = pk2(h[2], h[3]); } }
                *(GAS u32x4*)rp = w;
            }
    }
};
struct EpiResid {
    const float* xin_lat; const float* xin_ctx; float* out; const float* gate; float* part; float gmul;
    __device__ __forceinline__ void operator()(const AccT& acc, const Unit& u, int wr, int wc, int fr, int fq) const {
        const int r0 = u.pm * 256; const int mi = r0 < TL ? (r0 >> 12) : 8;
        const int cb = u.pn * 256 + wc * 32 + fq * 4;
        const float* gp = gate + (size_t)mi * NMODC + cb;
        f32x4 gv[2][2];
#pragma unroll
        for (int bj = 0; bj < 2; ++bj)
#pragma unroll
            for (int n = 0; n < 2; ++n) gv[bj][n] = *(const GAS f32x4*)(gp + bj * 128 + n * 16) * gmul;
        if (u.split) {
#pragma unroll
            for (int ai = 0; ai < 2; ++ai)
#pragma unroll
                for (int m = 0; m < 4; ++m) { const int row = r0 + ai * 128 + wr * 64 + m * 16 + fr;
#pragma unroll
                    for (int bj = 0; bj < 2; ++bj)
#pragma unroll
                        for (int n = 0; n < 2; ++n) *(GAS f32x4*)(part + ((size_t)(u.split - 1) * TC + (row - TL)) * DM + cb + bj * 128 + n * 16) = gv[bj][n] * acc[ai][bj][m][n]; }
        } else {
#pragma unroll
            for (int ai = 0; ai < 2; ++ai) {
                f32x4 xv[4][2][2];
#pragma unroll
                for (int m = 0; m < 4; ++m) { const int row = r0 + ai * 128 + wr * 64 + m * 16 + fr;
                    const float* xp = (row < TL ? xin_lat + (size_t)row * DM : xin_ctx + (size_t)(row - TL) * DM) + cb;
#pragma unroll
                    for (int bj = 0; bj < 2; ++bj)
#pragma unroll
                        for (int n = 0; n < 2; ++n) xv[m][bj][n] = *(const GAS f32x4*)(xp + bj * 128 + n * 16); }
                asm volatile("" ::: "memory");
#pragma unroll
                for (int m = 0; m < 4; ++m) { const int row = r0 + ai * 128 + wr * 64 + m * 16 + fr;
                    float* op = out + (size_t)row * DM + cb;
#pragma unroll
                    for (int bj = 0; bj < 2; ++bj)
#pragma unroll
                        for (int n = 0; n < 2; ++n) *(GAS f32x4*)(op + bj * 128 + n * 16) = xv[m][bj][n] + gv[bj][n] * acc[ai][bj][m][n]; }
                asm volatile("" ::: "memory");
            }
        }
    }
};
struct EpiWin0 {
    bf16_t *ckv, *cq, *y, *k0; float *ssq_kv, *ssq_q; const float* glu_b; const float* k_gain; const float2* rope32;
    __device__ __forceinline__ void operator()(const AccT& acc, const Unit& u, int wr, int wc, int fr, int fq) const {
        const int pn = u.pn; const int rbase = u.pm * 256 + wr * 64 + fr;
        if (pn < 2) {
            bf16_t* base = pn == 0 ? ckv : cq; const int pitch = pn == 0 ? 256 : 384; float* sq = pn == 0 ? ssq_kv : ssq_q;
#pragma unroll
            for (int ai = 0; ai < 2; ++ai)
#pragma unroll
                for (int m = 0; m < 4; ++m) {
                    const int row = rbase + ai * 128 + m * 16;
                    float ss = 0.f; bf16_t* p = base + (size_t)row * pitch + wc * 32 + fq * 4;
#pragma unroll
                    for (int bj = 0; bj < 2; ++bj)
#pragma unroll
                        for (int n = 0; n < 2; ++n) { const f32x4 v = acc[ai][bj][m][n]; ss += dot4(v); st_bf4(p + bj * 128 + n * 16, v); }
                    ss = fq_sum(ss); if (fq == 0) atomicAdd(sq + row, ss);
                    asm volatile("" ::: "memory");
                }
        } else if (pn == 2) {
#pragma unroll
            for (int ai = 0; ai < 2; ++ai)
#pragma unroll
                for (int m = 0; m < 4; ++m) {
                    const int row = rbase + ai * 128 + m * 16;
                    float ss = 0.f; bf16_t* p = cq + (size_t)row * 384 + 256 + wc * 32 + fq * 4;
#pragma unroll
                    for (int n = 0; n < 2; ++n) { const f32x4 v = acc[ai][0][m][n]; ss += dot4(v); st_bf4(p + n * 16, v); }
                    ss = fq_sum(ss); if (fq == 0) atomicAdd(ssq_q + row, ss);
                    if (wc == 0) {
                        float s2 = dot4(acc[ai][1][m][0]) + dot4(acc[ai][1][m][1]); s2 = fq_sum(s2);
                        const float r2 = rsqrtf(s2 * (1.f / 32.f) + EPS);
                        const int kvr = kvrow_of(row);
#pragma unroll
                        for (int n = 0; n < 2; ++n) { const int dd = n * 16 + fq * 4; f32x4 v = acc[ai][1][m][n] * r2 * *(const f32x4*)(k_gain + 64 + dd);
                            if (row < TL) v = rope4(v, rope32 + (size_t)(row & 4095) * 16 + (dd >> 1));
                            bf16_t* kp = k0 + (size_t)kvr * 768 + 64 + dd;
#pragma unroll
                            for (int h = 0; h < 8; ++h) st_bf4(kp + h * 96, v); }
                    }
                    asm volatile("" ::: "memory");
                }
        } else {
            const int cch = (pn - 3) * 128 + wc * 32 + fq * 4;
#pragma unroll
            for (int n = 0; n < 2; ++n) {
                const f32x4 ba = *(const f32x4*)(glu_b + cch + n * 16), bg = *(const f32x4*)(glu_b + 512 + cch + n * 16);
#pragma unroll
                for (int ai = 0; ai < 2; ++ai)
#pragma unroll
                    for (int m = 0; m < 4; ++m) {
                        const int row = rbase + ai * 128 + m * 16;
                        const f32x4 a = acc[ai][0][m][n] + ba, g = acc[ai][1][m][n] + bg; f32x4 o;
#pragma unroll
                        for (int j = 0; j < 4; ++j) o[j] = a[j] * sigmoidf_(g[j]);
                        st_bf4(y + (size_t)row * 512 + cch + n * 16, o);
                        asm volatile("" ::: "memory");
                    }
            }
        }
    }
};
struct EpiQup {
    const float* ssq_q; const float* q_gain; const float2* rope32; bf16_t* q0; float qscale;
    __device__ __forceinline__ void operator()(const AccT& acc, const Unit& u, int wr, int wc, int fr, int fq) const {
        const int pn = u.pn; const int rbase = u.pm * 256 + wr * 64 + fr;
        if (pn < 2) {
            const int h = pn * 4 + wc;
#pragma unroll
            for (int ai = 0; ai < 2; ++ai)
#pragma unroll
                for (int m = 0; m < 4; ++m) {
                    const int row = rbase + ai * 128 + m * 16;
                    const float rr = rsqrtf(ssq_q[row] * (1.f / 384.f) + EPS);
                    float ss = 0.f;
#pragma unroll
                    for (int bj = 0; bj < 2; ++bj)
#pragma unroll
                        for (int n = 0; n < 2; ++n) ss += dot4(acc[ai][bj][m][n]);
                    ss = fq_sum(ss) * rr * rr;
                    const float r2 = rsqrtf(ss * (1.f / 64.f) + EPS) * rr * qscale;
                    bf16_t* p = q0 + (size_t)row * 768 + h * 96 + fq * 4;
#pragma unroll
                    for (int bj = 0; bj < 2; ++bj)
#pragma unroll
                        for (int n = 0; n < 2; ++n) { const int dim = bj * 32 + n * 16 + fq * 4; st_bf4(p + bj * 32 + n * 16, acc[ai][bj][m][n] * r2 * *(const f32x4*)(q_gain + dim)); }
                    asm volatile("" ::: "memory");
                }
        } else {
#pragma unroll
            for (int ai = 0; ai < 2; ++ai)
#pragma unroll
                for (int m = 0; m < 4; ++m) {
                    const int row = rbase + ai * 128 + m * 16;
                    const float rr = rsqrtf(ssq_q[row] * (1.f / 384.f) + EPS);
#pragma unroll
                    for (int bj = 0; bj < 2; ++bj) {
                        const int h = 2 * wc + bj;
                        float ss = dot4(acc[ai][bj][m][0]) + dot4(acc[ai][bj][m][1]); ss = fq_sum(ss) * rr * rr;
                        const float r2 = rsqrtf(ss * (1.f / 32.f) + EPS) * rr;
#pragma unroll
                        for (int n = 0; n < 2; ++n) { const int dd = n * 16 + fq * 4; f32x4 v = acc[ai][bj][m][n] * r2 * *(const f32x4*)(q_gain + 64 + dd);
                            if (row < TL) v = rope4(v, rope32 + (size_t)(row & 4095) * 16 + (dd >> 1));
                            st_bf4(q0 + (size_t)row * 768 + h * 96 + 64 + dd, v * qscale); }
                    }
                    asm volatile("" ::: "memory");
                }
        }
    }
};
struct EpiKvup {
    const float* ssq_kv; const float* k_gain; bf16_t* k0; bf16_t* v0;
    __device__ __forceinline__ void operator()(const AccT& acc, const Unit& u, int wr, int wc, int fr, int fq) const {
        const int pn = u.pn; const int rbase = u.pm * 256 + wr * 64 + fr;
        if (pn < 2) {
            const int h = pn * 4 + wc;
#pragma unroll
            for (int ai = 0; ai < 2; ++ai)
#pragma unroll
                for (int m = 0; m < 4; ++m) {
                    const int row = rbase + ai * 128 + m * 16;
                    const float rr = rsqrtf(ssq_kv[row] * (1.f / 256.f) + EPS);
                    const int kvr = kvrow_of(row);
                    float ss = 0.f;
#pragma unroll
                    for (int bj = 0; bj < 2; ++bj)
#pragma unroll
                        for (int n = 0; n < 2; ++n) ss += dot4(acc[ai][bj][m][n]);
                    ss = fq_sum(ss) * rr * rr;
                    const float r2 = rsqrtf(ss * (1.f / 64.f) + EPS) * rr;
                    bf16_t* p = k0 + (size_t)kvr * 768 + h * 96 + fq * 4;
#pragma unroll
                    for (int bj = 0; bj < 2; ++bj)
#pragma unroll
                        for (int n = 0; n < 2; ++n) { const int dim = bj * 32 + n * 16 + fq * 4; st_bf4(p + bj * 32 + n * 16, acc[ai][bj][m][n] * r2 * *(const f32x4*)(k_gain + dim)); }
                    asm volatile("" ::: "memory");
                }
        } else {
            const int h = (pn - 2) * 4 + wc;
#pragma unroll
            for (int ai = 0; ai < 2; ++ai)
#pragma unroll
                for (int m = 0; m < 4; ++m) {
                    const int row = rbase + ai * 128 + m * 16;
                    const float rr = rsqrtf(ssq_kv[row] * (1.f / 256.f) + EPS);
                    bf16_t* p = v0 + (size_t)kvrow_of(row) * 512 + h * 64 + fq * 4;
#pragma unroll
                    for (int bj = 0; bj < 2; ++bj)
#pragma unroll
                        for (int n = 0; n < 2; ++n) st_bf4(p + bj * 32 + n * 16, acc[ai][bj][m][n] * rr);
                    asm volatile("" ::: "memory");
                }
        }
    }
};
struct EpiWin1 {
    bf16_t *qg, *qn, *kg, *vg, *kn, *vn; const float *gq_gain, *gk_gain, *nq_gain, *nk_gain; const float2* rope64; float qscale;
    __device__ __forceinline__ void operator()(const AccT& acc, const Unit& u, int wr, int wc, int fr, int fq) const {
        const int s = u.pn * 4 + wc;
        bf16_t* dst; int pitch; bool kvsel, rope; const float* gain; float sc = 1.f;
        if (s < 2)       { dst = kg + s * 64;        pitch = 128; kvsel = true;  rope = true;  gain = gk_gain; }
        else if (s < 4)  { dst = vg + (s - 2) * 64;  pitch = 128; kvsel = true;  rope = false; gain = nullptr; }
        else if (s < 12) { dst = kn + (s - 4) * 64;  pitch = 512; kvsel = true;  rope = false; gain = nk_gain; }
        else if (s < 20) { dst = vn + (s - 12) * 64; pitch = 512; kvsel = true;  rope = false; gain = nullptr; }
        else if (s < 28) { dst = qg + (s - 20) * 64; pitch = 512; kvsel = false; rope = true;  gain = gq_gain; sc = qscale; }
        else             { dst = qn + (s - 28) * 64; pitch = 512; kvsel = false; rope = false; gain = nq_gain; sc = qscale; }
#pragma unroll
        for (int ai = 0; ai < 2; ++ai)
#pragma unroll
            for (int m = 0; m < 4; ++m) {
                const int row = u.pm * 256 + ai * 128 + wr * 64 + m * 16 + fr;
                const int drow = kvsel ? kvrow_of(row) : row;
                float r2 = 1.f;
                if (gain) { float ss = 0.f;
#pragma unroll
                    for (int bj = 0; bj < 2; ++bj)
#pragma unroll
                        for (int n = 0; n < 2; ++n) ss += dot4(acc[ai][bj][m][n]);
                    ss = fq_sum(ss); r2 = rsqrtf(ss * (1.f / 64.f) + EPS); }
                bf16_t* p = dst + (size_t)drow * pitch + fq * 4;
#pragma unroll
                for (int bj = 0; bj < 2; ++bj)
#pragma unroll
                    for (int n = 0; n < 2; ++n) { const int dim = bj * 32 + n * 16 + fq * 4; f32x4 v = acc[ai][bj][m][n] * r2;
                        if (gain) v = v * *(const f32x4*)(gain + dim);
                        if (rope && row < TL) v = rope4(v, rope64 + (size_t)(row & 4095) * 32 + (dim >> 1));
                        st_bf4(p + bj * 32 + n * 16, v * sc); }
                if (m & 1) asm volatile("" ::: "memory");
            }
    }
};

__device__ __forceinline__ int crow(int r, int hi) { return (r & 3) + 8 * (r >> 2) + 4 * hi; }
typedef short v4i16_t __attribute__((ext_vector_type(4)));
__device__ __forceinline__ u32x2 vtr(const LAS unsigned char* p) { return __builtin_bit_cast(u32x2, __builtin_amdgcn_ds_read_tr16_b64_v4i16((LAS v4i16_t*)p)); }
__device__ __forceinline__ float max3f(float a, float b, float c) { float r; asm("v_max3_f32 %0, %1, %2, %3" : "=v"(r) : "v"(a), "v"(b), "v"(c)); return r; }
__device__ __forceinline__ float xhalf_max(float v) { auto rr = __builtin_amdgcn_permlane32_swap(__float_as_uint(v), __float_as_uint(v), false, false); return fmaxf(__uint_as_float(rr[0]), __uint_as_float(rr[1])); }
__device__ __forceinline__ float xhalf_sum(float v) { auto rr = __builtin_amdgcn_permlane32_swap(__float_as_uint(v), __float_as_uint(v), false, false); return __uint_as_float(rr[0]) + __uint_as_float(rr[1]); }
template <int DQK, bool NA>
__device__ __forceinline__ void attn_unit(LAS unsigned char* lds, const bf16_t* Qrow0, int qpitch, const bf16_t* Kb, int kpitch, const bf16_t* Vb, int vpitch,
                                          bf16_t* Orow0, int opitch, int ntiles, int rho0, int g4, const float* rpb_h, int wave_s) {
    constexpr int KP = DQK * 2 + 16, KBYTES = 128 * KP, VP = 192  , VBYTES = 128 * VP, CPR = DQK / 8, NKC = CPR / 4  , BUFB = KBYTES + VBYTES;
    const int lane = lane_opaque(), wid = wave_s, tid = wid * 64 + lane, r32 = lane & 31, hi = lane >> 5;
    bf16x8 qr[DQK / 16];
    { const bf16_t* qp = Qrow0 + (size_t)(wid * 32 + r32) * qpitch + hi * 8;
#pragma unroll
      for (int d0 = 0; d0 < DQK / 16; ++d0) qr[d0] = *(const GAS bf16x8*)(qp + d0 * 16); }
    const GAS bf16_t* Kg_ = (const GAS bf16_t*)Kb; const GAS bf16_t* Vg_ = (const GAS bf16_t*)Vb;
    const int nst = (ntiles + 1) >> 1;
    u32x4 kreg[NKC], vreg[2];
#define ATT_SROW(s) ((s) < 2 ? 128 * (s) : 128 * (s) + 64 * rho0)
#define ATT_LOAD(s) do { const int sr_ = ATT_SROW(s); \
        _Pragma("unroll") for (int i_ = 0; i_ < NKC; ++i_) { const int c_ = tid + 512 * i_; kreg[i_] = *(const GAS u32x4*)(Kg_ + (size_t)(sr_ + c_ / CPR) * kpitch + (c_ % CPR) * 8); } \
        _Pragma("unroll") for (int i_ = 0; i_ < 2; ++i_) { const int c_ = tid + 512 * i_; vreg[i_] = *(const GAS u32x4*)(Vg_ + (size_t)(sr_ + (c_ >> 3)) * vpitch + (c_ & 7) * 8); } } while (0)
#define ATT_STORE(b) do { LAS unsigned char* kb_ = lds + (b) * BUFB; \
        _Pragma("unroll") for (int i_ = 0; i_ < NKC; ++i_) { const int c_ = tid + 512 * i_; *(LAS u32x4*)(kb_ + (c_ / CPR) * KP + (c_ % CPR) * 16) = kreg[i_]; } \
        _Pragma("unroll") for (int i_ = 0; i_ < 2; ++i_) { const int c_ = tid + 512 * i_; *(LAS u32x4*)(kb_ + KBYTES + (c_ >> 3) * VP + (c_ & 7) * 16) = vreg[i_]; } } while (0)
    ATT_LOAD(0); ATT_STORE(0);
    __syncthreads();
    float m_run = 0.f, l_run = 0.f; f32x16 o0 = f32x16{}, o1 = f32x16{}, negm = f32x16{};
    bool first = true;
    const int r_w = g4 + (wid >> 1), rs = min(max(r_w - 4, 0), 56), cq_ = 32 * (wid & 1) + r32, cs = min(max(cq_ - 8, 0), 48);
    unsigned vmask = 0u; int bpbase = 0;
    if (NA) {
#pragma unroll
        for (int r = 0; r < 16; ++r) { const int ka_ = crow(r, hi), kc_ = ka_ + 32;
            vmask |= ((ka_ >= cs) && (ka_ < cs + 16) ? 1u : 0u) << r; vmask |= ((kc_ >= cs) && (kc_ < cs + 16) ? 1u : 0u) << (16 + r); }
        bpbase = (15 - cq_ + 4 * hi) * 4;
    }
    for (int s = 0; s < nst; ++s) {
        const int b = s & 1;
        if (s + 1 < nst) ATT_LOAD(s + 1);
#pragma unroll
        for (int sub = 0; sub < 2; ++sub) {
            const int t = 2 * s + sub;
            bool active = t < ntiles; int rho = 0;
            if (NA && t >= 4) { rho = rho0 + (t - 4); active = active && (rho >= rs) && (rho < rs + 8); }
            if (active) {
            float rowv = 0.f;
            if (NA && t >= 4) rowv = lane < 31 ? *(const GAS float*)(rpb_h + (rho - r_w + 7) * 31 + lane) * LOG2E : 0.f;
            const LAS unsigned char* kb = lds + b * BUFB + (sub * 64 + r32) * KP + hi * 16;
            f32x16 p0 = negm, p1 = negm;
            bf16x8 kf[DQK / 8];
#pragma unroll
            for (int d0 = 0; d0 < DQK / 16; ++d0) { kf[2 * d0] = *(const LAS bf16x8*)(kb + d0 * 32); kf[2 * d0 + 1] = *(const LAS bf16x8*)(kb + 32 * KP + d0 * 32); }
            __builtin_amdgcn_sched_barrier(0);
#pragma unroll
            for (int d0 = 0; d0 < DQK / 16; ++d0) {
                p0 = __builtin_amdgcn_mfma_f32_32x32x16_bf16(kf[2 * d0], qr[d0], p0, 0, 0, 0);
                p1 = __builtin_amdgcn_mfma_f32_32x32x16_bf16(kf[2 * d0 + 1], qr[d0], p1, 0, 0, 0);
            }
            const LAS unsigned char* vb = lds + b * BUFB + KBYTES + (sub * 64 + 4 * hi + ((lane & 15) >> 2)) * VP + (16 * ((lane >> 4) & 1) + 4 * (lane & 3)) * 2;
            u32x2 va0[4], va1[4], vc0[4], vc1[4];
#pragma unroll
            for (int j = 0; j < 4; ++j) { va0[j] = vtr(vb + (16 * j) * VP); va1[j] = vtr(vb + (16 * j + 8) * VP); vc0[j] = vtr(vb + (16 * j) * VP + 64); vc1[j] = vtr(vb + (16 * j + 8) * VP + 64); }
            __builtin_amdgcn_sched_barrier(0);
            if (NA && t >= 4) {
                const int rvi = __builtin_bit_cast(int, rowv);
#pragma unroll
                for (int r = 0; r < 16; ++r) {
                    const int o_ = 4 * ((r & 3) + 8 * (r >> 2));
                    const float ba = __builtin_bit_cast(float, __builtin_amdgcn_ds_bpermute(bpbase + o_, rvi)), bc = __builtin_bit_cast(float, __builtin_amdgcn_ds_bpermute(bpbase + o_ + 128, rvi));
                    p0[r] = ((vmask >> r) & 1u) ? p0[r] + ba : -1e30f; p1[r] = ((vmask >> (16 + r)) & 1u) ? p1[r] + bc : -1e30f;
                }
            }
            float mx = max3f(p0[0], p1[0], p0[1]), mx2 = max3f(p1[1], p0[2], p1[2]);
#pragma unroll
            for (int r = 3; r < 15; r += 2) { mx = max3f(mx, p0[r], p1[r]); mx2 = max3f(mx2, p0[r + 1], p1[r + 1]); }
            mx = xhalf_max(max3f(mx, mx2, max3f(p0[15], p1[15], p0[15])));
            if (first || __any(mx > 8.f)) {
                const float dl = first ? mx : fmaxf(mx, 0.f);
                m_run += dl;
                if (!first) { const float alpha = __builtin_amdgcn_exp2f(-dl); l_run *= alpha; o0 = o0 * alpha; o1 = o1 * alpha; }
#pragma unroll
                for (int r = 0; r < 16; ++r) { p0[r] -= dl; p1[r] -= dl; negm[r] = -m_run; }
                first = false;
            }
            float rsum = 0.f;
#pragma unroll
            for (int r = 0; r < 16; ++r) { p0[r] = __builtin_amdgcn_exp2f(p0[r]); p1[r] = __builtin_amdgcn_exp2f(p1[r]); rsum += p0[r] + p1[r]; }
            l_run += rsum;
            u32x4 pw[4];
#pragma unroll
            for (int j = 0; j < 2; ++j) {
                pw[j] = (u32x4){pk2(p0[8 * j], p0[8 * j + 1]), pk2(p0[8 * j + 2], p0[8 * j + 3]), pk2(p0[8 * j + 4], p0[8 * j + 5]), pk2(p0[8 * j + 6], p0[8 * j + 7])};
                pw[2 + j] = (u32x4){pk2(p1[8 * j], p1[8 * j + 1]), pk2(p1[8 * j + 2], p1[8 * j + 3]), pk2(p1[8 * j + 4], p1[8 * j + 5]), pk2(p1[8 * j + 6], p1[8 * j + 7])};
            }
#pragma unroll
            for (int j = 0; j < 4; ++j) {
                const u32x2 a0 = va0[j], a1 = va1[j], c0 = vc0[j], c1 = vc1[j];
                const bf16x8 pj = __builtin_bit_cast(bf16x8, pw[j]);
                o0 = __builtin_amdgcn_mfma_f32_32x32x16_bf16(__builtin_bit_cast(bf16x8, ((u32x4){a0.x, a0.y, a1.x, a1.y})), pj, o0, 0, 0, 0);
                o1 = __builtin_amdgcn_mfma_f32_32x32x16_bf16(__builtin_bit_cast(bf16x8, ((u32x4){c0.x, c0.y, c1.x, c1.y})), pj, o1, 0, 0, 0);
            }
            }
        }
        if (s + 1 < nst) ATT_STORE(b ^ 1);
        __syncthreads();
    }
    const float inv = 1.f / xhalf_sum(l_run);
    bf16_t* op = Orow0 + (size_t)(wid * 32 + r32) * opitch + 4 * hi;
#pragma unroll
    for (int rg = 0; rg < 4; ++rg) {
        st_bf4(op + 8 * rg, (f32x4){o0[4 * rg], o0[4 * rg + 1], o0[4 * rg + 2], o0[4 * rg + 3]} * inv);
        st_bf4(op + 32 + 8 * rg, (f32x4){o1[4 * rg], o1[4 * rg + 1], o1[4 * rg + 2], o1[4 * rg + 3]} * inv);
    }
#undef ATT_SROW
#undef ATT_LOAD
#undef ATT_STORE
}

#define XB_TMO      128
#define XB_XCNT(j)  (256  + 64 * (j))
#define XB_XSUB(j)  (1280 + 64 * (j))
#define XB_XGEN(j)  (2304 + 64 * (j))
#define XB_TOP      3328
#define XB_TOPGEN   3392
#define XCD_BAR_WORDS 3456
#define XB_SPIN_CAP (1u << 18)

__device__ __forceinline__ unsigned xb_ld(unsigned* p)              { return __hip_atomic_load(p, __ATOMIC_RELAXED, __HIP_MEMORY_SCOPE_AGENT); }
__device__ __forceinline__ unsigned xb_add(unsigned* p, unsigned v) { return __hip_atomic_fetch_add(p, v, __ATOMIC_RELAXED, __HIP_MEMORY_SCOPE_AGENT); }
__device__ __forceinline__ unsigned xb_xcc_id() { return (unsigned)__builtin_amdgcn_s_getreg((3 << 11) | 20) & 0xFu; }
#define XB_SPIN(cond, bar) do { unsigned _sp = 0; while (cond) { __builtin_amdgcn_s_sleep(1); \
    if ((++_sp & 255u) == 0u) { if (xb_ld(&(bar)[XB_TMO])) break; if (_sp > XB_SPIN_CAP) { atomicAdd(&(bar)[XB_TMO], 1u); break; } } } } while (0)

struct XcdBarrier {
    unsigned* bar; unsigned x;
    volatile LAS unsigned* st;
};

__device__ __forceinline__ XcdBarrier xcd_barrier_post(unsigned* bar, volatile LAS unsigned* st) {
    XcdBarrier b; b.bar = bar; b.x = xb_xcc_id(); b.st = st;
    if (threadIdx.x == 0) (void)xb_add(&bar[XB_XCNT(b.x)], 1u);
    return b;
}
__device__ __forceinline__ void xcd_barrier_complete(unsigned* bar, unsigned x, unsigned& nloc, unsigned& nx) {
    const unsigned G = gridDim.x * gridDim.y * gridDim.z;
    unsigned sum, cnt, mine, sp = 0u;
    for (;;) {
        sum = 0u; cnt = 0u; mine = 0u;
#pragma unroll
        for (unsigned j = 0; j < 16; ++j) { const unsigned c = xb_ld(&bar[XB_XCNT(j)]); sum += c; cnt += (c > 0u) ? 1u : 0u; mine = (j == x) ? c : mine; }
        if (sum == G) break;
        __builtin_amdgcn_s_sleep(1);
        if ((++sp & 255u) == 0u) { if (xb_ld(&bar[XB_TMO])) break; if (sp > XB_SPIN_CAP) { atomicAdd(&bar[XB_TMO], 1u); break; } }
    }
    nloc = mine > 0u ? mine : 1u; nx = cnt > 0u ? cnt : 1u;
}

__device__ __forceinline__ void xcd_barrier(const XcdBarrier& b) {
    asm volatile("s_waitcnt vmcnt(0)" ::: "memory");
    __syncthreads();
    if (threadIdx.x == 0) {
        unsigned* bar = b.bar;
        __builtin_amdgcn_s_waitcnt(0);
        unsigned nloc = b.st[0], nx = b.st[1];
        if (nloc == 0u) { xcd_barrier_complete(bar, b.x, nloc, nx); b.st[0] = nloc; b.st[1] = nx; }
        const unsigned old = xb_add(&bar[XB_XSUB(b.x)], 1u);
        const unsigned gen = old / nloc;
        if (old + 1u == (gen + 1u) * nloc) {
            __builtin_amdgcn_fence(__ATOMIC_RELEASE, "agent");
            asm volatile("s_waitcnt vmcnt(0)" ::: "memory");
            const unsigned og = xb_add(&bar[XB_TOP], 1u);
            const unsigned tg = og / nx;
            if (og + 1u == (tg + 1u) * nx) xb_add(&bar[XB_TOPGEN], 1u);
            else XB_SPIN(xb_ld(&bar[XB_TOPGEN]) == tg, bar);
            __builtin_amdgcn_fence(__ATOMIC_ACQUIRE, "agent");
            xb_add(&bar[XB_XGEN(b.x)], 1u);
            asm volatile("s_waitcnt vmcnt(0)" ::: "memory");
        } else {
            XB_SPIN(xb_ld(&bar[XB_XGEN(b.x)]) == gen, bar);
            __builtin_amdgcn_fence(__ATOMIC_ACQUIRE, "agent");
            asm volatile("s_waitcnt vmcnt(0)" ::: "memory");
        }
    }
    __syncthreads();
}

struct Args { const float* in[42]; float* out; unsigned char* ws; int ph_lo, ph_hi; };
enum { PT_P0 = 0, PT_NORM, PT_FFN_IN, PT_RESID, PT_WIN0, PT_UP0, PT_ATT0, PT_WIN1, PT_ATT1 };
constexpr int NPH = 22;

__device__ __forceinline__ int srccol(int kind, int p) {
    const int tile = p >> 8, q = p & 255, bj = q >> 7, wc = (q & 127) >> 5, i = q & 31;
    switch (kind) {
        case 1: return bj * FF + tile * 128 + wc * 32 + 8 * ((i >> 2) & 3) + 4 * (i >> 4) + (i & 3);
        case 2: if (tile == 0) return q; if (tile == 1) return 288 + q; if (tile == 2) return bj == 0 ? 288 + 256 + q : (wc == 0 ? 256 + i : -1); return 672 + bj * 512 + (tile - 3) * 128 + (q & 127);
        case 3: return tile < 2 ? (4 * tile + wc) * 96 + 32 * bj + i : (2 * wc + bj) * 96 + 64 + i;
        case 4: return tile < 2 ? (4 * tile + wc) * 128 + 32 * bj + i : (4 * (tile - 2) + wc) * 128 + 64 + 32 * bj + i;
        case 5: return 64 * (4 * tile + wc) + 32 * bj + i;
        default: return p;
    }
}
__device__ __forceinline__ void cvt_item(const float* W, int K, int N, int Npad, int kind, const float* kg, bf16_t* WT, LAS float* scr, int item, int lane) {
    const int nblk = Npad / 32, kb = item / nblk, nb = item % nblk, k0 = 64 * kb, n0 = 32 * nb;
    const int src0 = srccol(kind, n0 + (lane & 31)) - (lane & 31);
    float vv[32];
#pragma unroll
    for (int i = 0; i < 32; ++i) { const int kk = 2 * i + (lane >> 5); vv[i] = (src0 + (lane & 31)) >= 0 ? ((const GAS float*)W)[(size_t)(k0 + kk) * N + src0 + (lane & 31)] : 0.f; }
    if (kg) {
#pragma unroll
        for (int i = 0; i < 32; ++i) vv[i] *= kg[k0 + 2 * i + (lane >> 5)]; }
#pragma unroll
    for (int i = 0; i < 32; ++i) scr[(2 * i + (lane >> 5)) * 33 + (lane & 31)] = vv[i];
    asm volatile("s_waitcnt lgkmcnt(0)" ::: "memory");
    const int c = lane & 7;
#pragma unroll
    for (int j = 0; j < 4; ++j) { const int n = (lane >> 3) + 8 * j; const LAS float* s = scr + (8 * c) * 33 + n;
        u32x4 o; o.x = pk2(s[0 * 33], s[1 * 33]); o.y = pk2(s[2 * 33], s[3 * 33]); o.z = pk2(s[4 * 33], s[5 * 33]); o.w = pk2(s[6 * 33], s[7 * 33]);
        *(GAS u32x4*)(WT + (size_t)(n0 + n) * K + k0 + 8 * c) = o; }
    asm volatile("s_waitcnt lgkmcnt(0)" ::: "memory");
}

__global__ void __launch_bounds__(512, 2) fwd(Args a) {
    extern __shared__ __attribute__((aligned(16))) unsigned char lds_raw[];
    LAS unsigned char* lds = (LAS unsigned char*)lds_raw;
    cg::grid_group grid = cg::this_grid();
    const int wave = __builtin_amdgcn_readfirstlane((int)threadIdx.x >> 6);
    { volatile LAS unsigned* st0 = (volatile LAS unsigned*)(lds + 133120); if (threadIdx.x < 2) st0[threadIdx.x] = 0u; }
    __syncthreads();
    const XcdBarrier xbar = xcd_barrier_post((unsigned*)(a.ws + WS_BAR), (volatile LAS unsigned*)(lds + 133120));
    for (int ph = a.ph_lo; ph < a.ph_hi; ++ph) {
    int G_l = gridDim.x, bx_l = blockIdx.x; asm volatile("" : "+s"(G_l), "+s"(bx_l));
    const int G = G_l, bx = bx_l;
    const int vcu = (G % 8 == 0) ? (bx % 8) * (G / 8) + bx / 8 : bx;
    const int gw = bx * 8 + wave, NGW = G * 8;
    unsigned char* ws = a.ws; asm volatile("" : "+s"(ws));
    typedef const float* cfp_t; typedef __attribute__((address_space(4))) const cfp_t* kin_t;
    __attribute__((address_space(4))) const unsigned char* kp_ = (__attribute__((address_space(4))) const unsigned char*)__builtin_amdgcn_kernarg_segment_ptr(); asm volatile("" : "+s"(kp_));
    const kin_t inp = (kin_t)kp_;
    float* ssq = (float*)(ws + WS_SSQ); float* mods = (float*)(ws + WS_MODS);
    float2* rope64 = (float2*)(ws + WS_ROPE64); float2* rope32 = (float2*)(ws + WS_ROPE32);
    bf16_t* Wb = (bf16_t*)(ws + WS_W); float* X = (float*)(ws + WS_X); bf16_t* H = (bf16_t*)(ws + WS_H); unsigned char* BIG = ws + WS_BIG;
    bf16_t* HID = (bf16_t*)BIG;
    {
        const int L = ph >= 12 ? 1 : 0;
        int pt, sub;
        switch (ph) {
            case 0: pt = PT_P0; sub = 0; break;
            case 1: case 12: pt = PT_NORM; sub = 0; break;
            case 4: case 15: pt = PT_NORM; sub = 1; break;
            case 9: case 19: pt = PT_NORM; sub = 2; break;
            case 2: case 13: pt = PT_FFN_IN; sub = 0; break;
            case 10: case 20: pt = PT_FFN_IN; sub = 2; break;
            case 3: case 14: pt = PT_RESID; sub = 0; break;
            case 8: case 18: pt = PT_RESID; sub = 1; break;
            case 11: case 21: pt = PT_RESID; sub = 2; break;
            case 5: pt = PT_WIN0; sub = 0; break;
            case 6: pt = PT_UP0; sub = 0; break;
            case 7: pt = PT_ATT0; sub = 0; break;
            case 16: pt = PT_WIN1; sub = 0; break;
            default: pt = PT_ATT1; sub = 0; break;
        }
        const bool first = (ph <= 3);
        const bool tail = (L == 1 && ph >= 18);
        const int Mrows = tail ? TL : TA;
        const float* modL = mods + (size_t)L * 9 * NMODC;
        const int ib = L ? 26 : 4;

        if (pt == PT_P0) {
            const int lane = lane_opaque(), tid = wave * 64 + lane;
            LAS float* sil = (LAS float*)lds; LAS float* red = (LAS float*)(lds + 36864);
            for (int i = tid; i < 9 * 1024; i += 512) { const int mi = i >> 10, k = i & 1023; const float c = mi < 8 ? inp[1][mi * 1024 + k] : inp[3][k]; sil[i] = c / (1.f + __expf(-c)); }
            __syncthreads();
            for (int it = bx; it < 288; it += G) {
                const int l = it / 144, cgp = it % 144, col = cgp * 64 + lane, k0 = wave * 128;
                const float* mw = inp[l ? 26 : 4] + (size_t)k0 * NMODC + col;
                float ac[9];
#pragma unroll
                for (int mi = 0; mi < 9; ++mi) ac[mi] = 0.f;
#pragma unroll 4
                for (int k = 0; k < 128; ++k) { const float w = ((const GAS float*)mw)[(size_t)k * NMODC];
#pragma unroll
                    for (int mi = 0; mi < 9; ++mi) ac[mi] += sil[mi * 1024 + k0 + k] * w; }
#pragma unroll
                for (int mi = 0; mi < 9; ++mi) red[(wave * 9 + mi) * 64 + lane] = ac[mi];
                __syncthreads();
                for (int idx = tid; idx < 576; idx += 512) { const int mi = idx >> 6, ln = idx & 63; float s = inp[l ? 27 : 5][cgp * 64 + ln];
#pragma unroll
                    for (int w = 0; w < 8; ++w) s += red[(w * 9 + mi) * 64 + ln];
                    mods[((size_t)l * 9 + mi) * NMODC + cgp * 64 + ln] = s; }
                __syncthreads();
            }
            __syncthreads();
            LAS float* scr = (LAS float*)(lds + wave * 8448);
            for (int j = 0; j < 14; ++j) {
                int idx, K, N, Npad, kind, kgi = -1; size_t off;
                switch (j) {
                    case 0: idx = 7; K = 1024; N = 5632; Npad = 5632; kind = 1; off = W_F1I0; break;
                    case 1: idx = 8; K = 2816; N = 1024; Npad = 1024; kind = 0; off = W_F1O0; break;
                    case 2: idx = 10; K = 1024; N = 1696; Npad = 1792; kind = 2; off = W_WIN0; break;
                    case 3: idx = 12; K = 384; N = 768; Npad = 768; kind = 3; kgi = 11; off = W_UQ; break;
                    case 4: idx = 14; K = 256; N = 1024; Npad = 1024; kind = 4; kgi = 13; off = W_UKV; break;
                    case 5: idx = 22; K = 1024; N = 1024; Npad = 1024; kind = 0; off = W_WO0; break;
                    case 6: idx = 24; K = 1024; N = 5632; Npad = 5632; kind = 1; off = W_F2I0; break;
                    case 7: idx = 25; K = 2816; N = 1024; Npad = 1024; kind = 0; off = W_F2O0; break;
                    case 8: idx = 29; K = 1024; N = 5632; Npad = 5632; kind = 1; off = W_F1I1; break;
                    case 9: idx = 30; K = 2816; N = 1024; Npad = 1024; kind = 0; off = W_F1O1; break;
                    case 10: idx = 32; K = 1024; N = 2304; Npad = 2304; kind = 5; off = W_WIN1; break;
                    case 11: idx = 38; K = 1024; N = 1024; Npad = 1024; kind = 0; off = W_WO1; break;
                    case 12: idx = 40; K = 1024; N = 5632; Npad = 5632; kind = 1; off = W_F2I1; break;
                    default: idx = 41; K = 2816; N = 1024; Npad = 1024; kind = 0; off = W_F2O1; break;
                }
                const int nitems = (K / 64) * (Npad / 32);
                const float* kg = kgi >= 0 ? inp[kgi] : nullptr;
                for (int it = gw; it < nitems; it += NGW) cvt_item(inp[idx], K, N, Npad, kind, kg, Wb + off, scr, it, lane);
            }
            const int gt = bx * 512 + tid, NT = G * 512;
            for (int i = gt; i < 4096 * 32; i += NT) { const int t = i >> 5, p = i & 31; const float pos = p < 16 ? (float)(t >> 6) : (float)(t & 63);
                const float inv = powf(10000.f, -(float)(p & 15) / 16.f); float s, c; sincosf(pos * inv, &s, &c); rope64[i] = make_float2(c, s); }
            for (int i = gt; i < 4096 * 16; i += NT) { const int t = i >> 4, p = i & 15; const float pos = p < 8 ? (float)(t >> 6) : (float)(t & 63);
                const float inv = powf(10000.f, -(float)(p & 7) / 8.f); float s, c; sincosf(pos * inv, &s, &c); rope32[i] = make_float2(c, s); }
            for (int i = gt; i < 2 * TA; i += NT) ssq[i] = 0.f;
        } else if (pt == PT_NORM) {
            const int lane = lane_opaque();
            const float* xl = first ? inp[0] : X; const float* xc = first ? inp[2] : X + (size_t)TL * DM;
            const float* gain = inp[ib + (sub == 0 ? 2 : sub == 1 ? 5 : (L ? 13 : 19))];
            const int shi = sub * 3, sci = sub * 3 + 1;
            for (int row = gw; row < Mrows; row += NGW) {
                const float* xr = row < TL ? xl + (size_t)row * DM : xc + (size_t)(row - TL) * DM; const int mi = row < TL ? (row >> 12) : 8;
                f32x4 v[4]; float ss = 0.f;
#pragma unroll
                for (int j = 0; j < 4; ++j) { v[j] = *(const GAS f32x4*)(xr + lane * 4 + 256 * j); ss += dot4(v[j]); }
                if (ph > 1 && row >= TL) {
                    const float* pp = (const float*)(BIG + 188 * MiB) + (size_t)(row - TL) * DM + lane * 4; ss = 0.f;
#pragma unroll
                    for (int j = 0; j < 4; ++j) {
                        f32x4 xv = ph == 4 ? *(const GAS f32x4*)(inp[2] + (size_t)(row - TL) * DM + lane * 4 + 256 * j) : v[j];
#pragma unroll
                        for (int s4 = 0; s4 < 4; ++s4) xv = xv + *(const GAS f32x4*)(pp + (size_t)s4 * TC * DM + 256 * j);
                        v[j] = xv; ss += dot4(xv); *(GAS f32x4*)(X + (size_t)row * DM + lane * 4 + 256 * j) = xv; }
                }
                const float rstd = rsqrtf(wave_sum(ss) * (1.f / DM) + EPS);
                const float* mp = modL + (size_t)mi * NMODC;
#pragma unroll
                for (int j = 0; j < 4; ++j) { const int col = lane * 4 + 256 * j;
                    const f32x4 g = *(const GAS f32x4*)(gain + col), sc = *(const GAS f32x4*)(mp + sci * 1024 + col), sh = *(const GAS f32x4*)(mp + shi * 1024 + col);
                    st_bf4(H + (size_t)row * DM + col, v[j] * rstd * g * (sc + 1.f) + sh); }
            }
        } else if (pt == PT_FFN_IN) {
            const size_t off = L ? (sub == 0 ? W_F1I1 : W_F2I1) : (sub == 0 ? W_F1I0 : W_F2I0);
            pg8::Gemm g{H, Wb + off, Mrows, 5632, 1024, 1024}; pg8::StaticOrder S; S.init(Mrows, 5632, 1024, G, bx);
            EpiSwiglu E{HID};
            pg8::gemm_phase<EpiSwiglu>(lds, g, S, E, wave);
        } else if (pt == PT_RESID) {
            const bool mix = (sub == 1);
            const size_t off = L ? (sub == 0 ? W_F1O1 : sub == 1 ? W_WO1 : W_F2O1) : (sub == 0 ? W_F1O0 : sub == 1 ? W_WO0 : W_F2O0);
            const int K = mix ? 1024 : FF;
            pg8::Gemm g{mix ? H : HID, Wb + off, Mrows, 1024, K, K}; pg8::StaticOrder S; S.init(TL, 1024, K, G, bx, tail ? 0 : TC);
            const bool lastp = (ph == NPH - 1);
            EpiResid E{first ? inp[0] : X, first ? inp[2] : X + (size_t)TL * DM, lastp ? a.out : X, modL + (sub == 0 ? 2 : sub == 1 ? 5 : 8) * 1024, (float*)(BIG + 188 * MiB), mix ? 1.f : 0.5f};
            pg8::gemm_phase<EpiResid>(lds, g, S, E, wave);
        } else if (pt == PT_WIN0) {
            pg8::Gemm g{H, Wb + W_WIN0, TA, 1792, 1024, 1024}; pg8::StaticOrder S; S.init(TA, 1792, 1024, G, bx);
            EpiWin0 E{(bf16_t*)(BIG + B0_CKV), (bf16_t*)(BIG + B0_CQ), (bf16_t*)(BIG + B0_Y), (bf16_t*)(BIG + B0_K), ssq, ssq + TA, inp[17], inp[16], rope32};
            pg8::gemm_phase<EpiWin0>(lds, g, S, E, wave);
        } else if (pt == PT_UP0) {
            { pg8::Gemm g{(bf16_t*)(BIG + B0_CQ), Wb + W_UQ, TA, 768, 384, 384}; pg8::StaticOrder S; S.init(TA, 768, 384, G, bx);
              EpiQup E{ssq + TA, inp[15], rope32, (bf16_t*)(BIG + B0_Q), 0.10206207261596575f * LOG2E};
              pg8::gemm_phase<EpiQup>(lds, g, S, E, wave); }
            { pg8::Gemm g{(bf16_t*)(BIG + B0_CKV), Wb + W_UKV, TA, 1024, 256, 256}; pg8::StaticOrder S; S.init(TA, 1024, 256, G, bx);
              EpiKvup E{ssq, inp[16], (bf16_t*)(BIG + B0_K), (bf16_t*)(BIG + B0_V)};
              pg8::gemm_phase<EpiKvup>(lds, g, S, E, wave); }
            {
                const bf16_t* Y = (const bf16_t*)(BIG + B0_Y);
                const float *dw_w = inp[18], *dw_b = inp[19], *ln_g = inp[20], *ln_b = inp[21];
                LAS float* red = (LAS float*)lds;
                const int lane = lane_opaque(), tid = wave * 64 + lane;
                const int tg = tid >> 8, cp = tid & 255, w4 = (tid >> 6) & 3;
                for (int un = bx; un < TA / 16; un += G) {
                    const int row0 = un * 16 + tg * 8;
                    int lo, hi_;
                    if (row0 < TL) { lo = row0 & ~4095; hi_ = lo + 4096; } else { lo = TL + ((row0 - TL) & ~255); hi_ = lo + 256; }
                    unsigned yw[38];
#pragma unroll
                    for (int i = 0; i < 38; ++i) { const int r = row0 - 15 + i; yw[i] = (r >= lo && r < hi_) ? *(const GAS unsigned*)(Y + (size_t)r * 512 + 2 * cp) : 0u; }
                    float a0[8], a1[8];
                    const float2 bb = *(const float2*)(dw_b + 2 * cp);
#pragma unroll
                    for (int t = 0; t < 8; ++t) { a0[t] = bb.x; a1[t] = bb.y; }
#pragma unroll
                    for (int k = 0; k < 31; ++k) { const float2 w = *(const float2*)(dw_w + k * 512 + 2 * cp);
#pragma unroll
                        for (int t = 0; t < 8; ++t) { a0[t] += bflo(yw[t + k]) * w.x; a1[t] += bfhi(yw[t + k]) * w.y; }
                        if ((k & 3) == 3) asm volatile("" ::: "memory"); }
#pragma unroll
                    for (int t = 0; t < 8; ++t) { const float s = wave_sum(a0[t] + a1[t]), q = wave_sum(a0[t] * a0[t] + a1[t] * a1[t]);
                        if (lane == 0) { red[((tg * 4 + w4) * 8 + t) * 2] = s; red[((tg * 4 + w4) * 8 + t) * 2 + 1] = q; } }
                    __syncthreads();
                    const float2 gg = *(const float2*)(ln_g + 2 * cp), lb = *(const float2*)(ln_b + 2 * cp);
#pragma unroll
                    for (int t = 0; t < 8; ++t) { float s = 0.f, q = 0.f;
#pragma unroll
                        for (int w = 0; w < 4; ++w) { s += red[((tg * 4 + w) * 8 + t) * 2]; q += red[((tg * 4 + w) * 8 + t) * 2 + 1]; }
                        const float mu = s * (1.f / 512.f), var = fmaxf(q * (1.f / 512.f) - mu * mu, 0.f), rstd = rsqrtf(var + EPS);
                        const float y0 = (a0[t] - mu) * rstd * gg.x + lb.x, y1 = (a1[t] - mu) * rstd * gg.y + lb.y;
                        *(unsigned*)(H + (size_t)(row0 + t) * DM + 512 + 2 * cp) = pk2(y0 * sigmoidf_(y0), y1 * sigmoidf_(y1)); }
                    __syncthreads();
                }
            }
        } else if (pt == PT_ATT0) {
            const bf16_t* Q0 = (const bf16_t*)(BIG + B0_Q); const bf16_t* K0 = (const bf16_t*)(BIG + B0_K); const bf16_t* V0 = (const bf16_t*)(BIG + B0_V);
            for (int un = vcu; un < 1024 + 64; un += G) {
                if (un < 1024) { const int bh = un >> 4, qb = un & 15, b = bh >> 3, h = bh & 7; const size_t qrow = (size_t)b * 4096 + qb * 256;
                    attn_unit<96, false>(lds, Q0 + qrow * 768 + h * 96, 768, K0 + (size_t)b * KVB * 768 + h * 96, 768, V0 + (size_t)b * KVB * 512 + h * 64, 512, H + qrow * DM + h * 64, DM, 68, 0, 0, nullptr, wave);
                } else { const int idx = un - 1024, b = idx >> 3, h = idx & 7; const size_t qrow = (size_t)TL + b * 256;
                    attn_unit<96, false>(lds, Q0 + qrow * 768 + h * 96, 768, K0 + (size_t)b * KVB * 768 + h * 96, 768, V0 + (size_t)b * KVB * 512 + h * 64, 512, H + qrow * DM + h * 64, DM, 4, 0, 0, nullptr, wave); }
            }
        } else if (pt == PT_WIN1) {
            pg8::Gemm g{H, Wb + W_WIN1, TA, 2304, 1024, 1024}; pg8::StaticOrder S; S.init(TA, 2304, 1024, G, bx);
            EpiWin1 E{(bf16_t*)(BIG + B1_QG), (bf16_t*)(BIG + B1_QN), (bf16_t*)(BIG + B1_KG), (bf16_t*)(BIG + B1_VG), (bf16_t*)(BIG + B1_KN), (bf16_t*)(BIG + B1_VN),
                      inp[33], inp[34], inp[35], inp[36], rope64, 0.125f * LOG2E};
            pg8::gemm_phase<EpiWin1>(lds, g, S, E, wave);
        } else if (pt == PT_ATT1) {
            const bf16_t* Qg = (const bf16_t*)(BIG + B1_QG); const bf16_t* Qn = (const bf16_t*)(BIG + B1_QN); const bf16_t* Kg = (const bf16_t*)(BIG + B1_KG);
            const bf16_t* Vg = (const bf16_t*)(BIG + B1_VG); const bf16_t* Kn = (const bf16_t*)(BIG + B1_KN); const bf16_t* Vn = (const bf16_t*)(BIG + B1_VN);
            for (int un = vcu; un < 2048; un += G) {
                const int u2 = un & 1023, bh = u2 >> 4, qb = u2 & 15, b = bh >> 3, h = bh & 7; const size_t qrow = (size_t)b * 4096 + qb * 256;
                if (un < 1024) {
                    attn_unit<64, false>(lds, Qg + qrow * 512 + h * 64, 512, Kg + (size_t)b * KVB * 128 + (h >> 2) * 64, 128, Vg + (size_t)b * KVB * 128 + (h >> 2) * 64, 128, H + qrow * DM + h * 64, DM, 68, 0, 0, nullptr, wave);
                } else {
                    const int g4 = qb * 4, rho0 = min(max(g4 - 4, 0), 56), rho1 = min(max(g4 + 3 - 4, 0), 56) + 7;
                    attn_unit<64, true>(lds, Qn + qrow * 512 + h * 64, 512, Kn + (size_t)b * KVB * 512 + h * 64, 512, Vn + (size_t)b * KVB * 512 + h * 64, 512, H + qrow * DM + 512 + h * 64, DM,
                                        4 + (rho1 - rho0 + 1), rho0, g4, inp[37] + h * 15 * 31, wave);
                }
            }
        }
        if (ph + 1 < a.ph_hi) { if (ph == 0) grid.sync(); else xcd_barrier(xbar); }
    }
    }
}

extern "C" void kernel_launch(void* const* d_in, const int* in_sizes, int n_in, void* d_out, int out_size, void* d_ws, size_t ws_size, hipStream_t stream) {
    static int grid = 0;
    if (grid == 0) {
        int dev = 0, cus = 0;
        if (hipGetDevice(&dev) != hipSuccess || hipDeviceGetAttribute(&cus, hipDeviceAttributeMultiprocessorCount, dev) != hipSuccess) { fprintf(stderr, "kernel_launch: device query failed\n"); grid = -1; return; }
        if (hipFuncSetAttribute((const void*)fwd, hipFuncAttributeMaxDynamicSharedMemorySize, LDS_BYTES) != hipSuccess) { fprintf(stderr, "kernel_launch: hipFuncSetAttribute failed\n"); grid = -1; return; }
        int per_cu = 0;
        if (hipOccupancyMaxActiveBlocksPerMultiprocessor(&per_cu, (const void*)fwd, 512, LDS_BYTES) != hipSuccess || per_cu < 1) fprintf(stderr, "kernel_launch: occupancy query says %d\n", per_cu);
        (void)hipGetLastError();
        grid = cus;
        if (n_in != 42 || ws_size < 512 * MiB) fprintf(stderr, "kernel_launch: unexpected n_in %d / ws %zu\n", n_in, ws_size);
    }
    if (grid < 0) return;
    Args a{};
    for (int i = 0; i < 42; ++i) a.in[i] = (const float*)d_in[i];
    a.out = (float*)d_out; a.ws = (unsigned char*)d_ws;
    if (hipMemsetAsync((char*)d_ws + WS_BAR, 0, XCD_BAR_WORDS * 4, stream) != hipSuccess) { fprintf(stderr, "kernel_launch: memset failed\n"); return; }
#if ONE_LAUNCH
    a.ph_lo = 0; a.ph_hi = NPH;
    void* args[] = {&a};
    hipError_t e = hipLaunchCooperativeKernel((const void*)fwd, dim3(grid), dim3(512), args, LDS_BYTES, stream);
    if (e != hipSuccess) fprintf(stderr, "kernel_launch: cooperative launch failed: %s\n", hipGetErrorString(e));
#else
    for (int ph = 0; ph < NPH; ++ph) { a.ph_lo = ph; a.ph_hi = ph + 1; hipLaunchKernelGGL(fwd, dim3(grid), dim3(512), LDS_BYTES, stream, a); }
#endif
}
```
